# Optimizing an MI355X kernel written in HIP

```python
import math
import jax, jax.numpy as jnp
from jax import lax
import numpy as np

D_MODEL = 1024
BATCH = 8
SEQ = 4096
DEPTH = 1

CHUNK = 64
Q_BLOCK = 128
N_MEM = 256
HEAD_DIM = 64
A_HEADS = 4
A_QK_DIM = HEAD_DIM
A_V_DIM = 2 * HEAD_DIM
B_HEADS = 8
B_DIM = HEAD_DIM
B_LEFT_CHUNKS = 8
B_BAND = B_LEFT_CHUNKS + 1
REL_CLIP = 128
C_HEADS = 4
C_DIM = 128
D_FF = 2816
ROPE_THETA = 10000.0
EPS = 1e-6
NEG = -1e30
N_BRANCH = 3

A_Q = A_HEADS * 2 * A_QK_DIM
A_V = A_HEADS * A_V_DIM
B_W = B_HEADS * B_DIM
C_W = C_HEADS * C_DIM
BRANCH_W = 512
IN_COLS = 2 * A_Q + A_V + 3 * B_W + C_W

kernel_name = "hybrid_streaming_diff_chunk_mem_layer"


def rmsnorm(x, g):
    xf = x.astype(jnp.float32)
    y = xf * lax.rsqrt(jnp.mean(xf * xf, axis=-1, keepdims=True) + EPS)
    return (y * g.astype(jnp.float32)).astype(x.dtype)


def rope(x):
    s, d = x.shape[1], x.shape[-1]
    half = d // 2
    inv = ROPE_THETA ** (-jnp.arange(half, dtype=jnp.float32) / half)
    ang = jnp.arange(s, dtype=jnp.float32)[:, None] * inv[None, :]
    shp = (1, s) + (1,) * (x.ndim - 3) + (half,)
    cos, sin = jnp.cos(ang).reshape(shp), jnp.sin(ang).reshape(shp)
    xf = x.astype(jnp.float32)
    x1, x2 = xf[..., :half], xf[..., half:]
    return jnp.concatenate([x1 * cos - x2 * sin, x2 * cos + x1 * sin], axis=-1).astype(x.dtype)


def swiglu(h, wg, wu, wd):
    return (jax.nn.silu(h @ wg) * (h @ wu)) @ wd


def diff_attention(q, k, v, lam, lambda_init, sub_gain):
    b, s, h = q.shape[0], q.shape[1], q.shape[2]
    scale = A_QK_DIM ** -0.5
    chunk_id = jnp.arange(s) // CHUNK
    outs = []
    for i in range(s // Q_BLOCK):
        q0, q1 = i * Q_BLOCK, (i + 1) * Q_BLOCK
        kb, vb = k[:, :q1], v[:, :q1]
        sc = jnp.einsum('bqhcd,bkhcd->bhcqk', q[:, q0:q1], kb).astype(jnp.float32) * scale
        mask = chunk_id[q0:q1, None] >= chunk_id[None, :q1]
        sc = jnp.where(mask[None, None, None], sc, NEG)
        p = jax.nn.softmax(sc, axis=-1)
        a = p[:, :, 0] - lam * p[:, :, 1]
        outs.append(jnp.einsum('bhqk,bkhd->bqhd', a.astype(v.dtype), vb))
    o = jnp.concatenate(outs, axis=1)
    o = rmsnorm(o, sub_gain) * (1.0 - lambda_init)
    return o.reshape(b, s, h * A_V_DIM)


def chunk_band_attention(q, k, v, rel_table):
    b, s, h, d = q.shape
    nc = s // CHUNK
    scale = d ** -0.5
    qc = q.reshape(b, nc, CHUNK, h, d)
    pad = ((0, 0), (B_LEFT_CHUNKS, 0), (0, 0), (0, 0), (0, 0))
    kp = jnp.pad(k.reshape(b, nc, CHUNK, h, d), pad)
    vp = jnp.pad(v.reshape(b, nc, CHUNK, h, d), pad)
    band_idx = jnp.arange(nc)[:, None] + jnp.arange(B_BAND)[None, :]
    kb = kp[:, band_idx].reshape(b, nc, B_BAND * CHUNK, h, d)
    vb = vp[:, band_idx].reshape(b, nc, B_BAND * CHUNK, h, d)
    sc = jnp.einsum('bcqhd,bckhd->bchqk', qc, kb).astype(jnp.float32) * scale
    qpos = jnp.arange(CHUNK) + B_LEFT_CHUNKS * CHUNK
    kpos = jnp.arange(B_BAND * CHUNK)
    rel = jnp.clip(qpos[:, None] - kpos[None, :], -REL_CLIP, REL_CLIP) + REL_CLIP
    sc = sc + rel_table.astype(jnp.float32)[:, rel][None, None]
    valid = jnp.repeat(band_idx >= B_LEFT_CHUNKS, CHUNK, axis=1)
    sc = jnp.where(valid[None, :, None, None, :], sc, NEG)
    p = jax.nn.softmax(sc, axis=-1)
    o = jnp.einsum('bchqk,bckhd->bcqhd', p.astype(v.dtype), vb)
    return o.reshape(b, s, h * d)


def memory_attention(q, mk, mv):
    b, s, h, d = q.shape
    sc = jnp.einsum('bshd,bmhd->bhsm', q, mk).astype(jnp.float32) * (d ** -0.5)
    p = jax.nn.softmax(sc, axis=-1)
    return jnp.einsum('bhsm,bmhd->bshd', p.astype(mv.dtype), mv).reshape(b, s, h * d)


def setup_inputs(seed: int = 0) -> dict:
    key = jax.random.key(seed)
    ks = iter(jax.random.split(key, 40))
    L, D, F = DEPTH, D_MODEL, D_FF

    def w(shape, fan_in):
        return jax.random.normal(next(ks), shape, jnp.float32) * (fan_in ** -0.5)

    def gain(shape):
        return 1.0 + 0.01 * jax.random.normal(next(ks), shape, jnp.float32)

    def small(shape, s):
        return s * jax.random.normal(next(ks), shape, jnp.float32)

    return {
        "x": jax.random.normal(next(ks), (BATCH, SEQ, D), jnp.float32),
        "mem": jax.random.normal(next(ks), (BATCH, N_MEM, D), jnp.float32),
        "ffn1_norm": gain((L, D)),
        "ffn1_wg": w((L, D, F), D),
        "ffn1_wu": w((L, D, F), D),
        "ffn1_wd": w((L, F, D), F),
        "mix_norm": gain((L, D)),
        "w_in": w((L, D, IN_COLS), D),
        "a_q_norm": gain((L, A_QK_DIM)),
        "a_k_norm": gain((L, A_QK_DIM)),
        "a_lambda": small((L, 4, A_QK_DIM), 0.1),
        "a_sub_norm": gain((L, A_V_DIM)),
        "b_q_norm": gain((L, B_DIM)),
        "b_k_norm": gain((L, B_DIM)),
        "b_rel_bias": small((L, B_HEADS, 2 * REL_CLIP + 1), 0.1),
        "mem_norm": gain((L, D)),
        "w_mem_kv": w((L, D, 2 * C_W), D),
        "c_q_norm": gain((L, C_DIM)),
        "c_k_norm": gain((L, C_DIM)),
        "w_gate": w((L, D, N_BRANCH * D), D),
        "b_gate": small((L, N_BRANCH * D), 0.01),
        "w_branch": w((L, N_BRANCH, BRANCH_W, D), BRANCH_W),
        "w_out": w((L, D, D), D),
        "ffn2_norm": gain((L, D)),
        "ffn2_wg": w((L, D, F), D),
        "ffn2_wu": w((L, D, F), D),
        "ffn2_wd": w((L, F, D), F),
        "final_norm": gain((L, D)),
    }


def reference(x, mem, ffn1_norm, ffn1_wg, ffn1_wu, ffn1_wd, mix_norm, w_in,
              a_q_norm, a_k_norm, a_lambda, a_sub_norm, b_q_norm, b_k_norm, b_rel_bias,
              mem_norm, w_mem_kv, c_q_norm, c_k_norm, w_gate, b_gate, w_branch, w_out,
              ffn2_norm, ffn2_wg, ffn2_wu, ffn2_wd, final_norm):
    b, s, d = x.shape
    m = mem.shape[1]
    split_at = list(np.cumsum([A_Q, A_Q, A_V, B_W, B_W, B_W]))
    for l in range(DEPTH):
        x = x + 0.5 * swiglu(rmsnorm(x, ffn1_norm[l]), ffn1_wg[l], ffn1_wu[l], ffn1_wd[l])

        h = rmsnorm(x, mix_norm[l])
        proj = h @ w_in[l]
        aq, ak, av, bq, bk, bv, cq = jnp.split(proj, [int(i) for i in split_at], axis=-1)

        lambda_init = 0.8 - 0.6 * math.exp(-0.3 * l)
        lp = a_lambda[l].astype(jnp.float32)
        lam = jnp.exp(jnp.sum(lp[0] * lp[1])) - jnp.exp(jnp.sum(lp[2] * lp[3])) + lambda_init
        aq = rope(rmsnorm(aq.reshape(b, s, A_HEADS, 2, A_QK_DIM), a_q_norm[l]))
        ak = rope(rmsnorm(ak.reshape(b, s, A_HEADS, 2, A_QK_DIM), a_k_norm[l]))
        av = av.reshape(b, s, A_HEADS, A_V_DIM)
        o_a = diff_attention(aq, ak, av, lam, lambda_init, a_sub_norm[l])

        bq = rmsnorm(bq.reshape(b, s, B_HEADS, B_DIM), b_q_norm[l])
        bk = rmsnorm(bk.reshape(b, s, B_HEADS, B_DIM), b_k_norm[l])
        bv = bv.reshape(b, s, B_HEADS, B_DIM)
        o_b = chunk_band_attention(bq, bk, bv, b_rel_bias[l])

        mkv = rmsnorm(mem, mem_norm[l]) @ w_mem_kv[l]
        mk, mv = jnp.split(mkv, 2, axis=-1)
        mk = rmsnorm(mk.reshape(b, m, C_HEADS, C_DIM), c_k_norm[l])
        mv = mv.reshape(b, m, C_HEADS, C_DIM)
        cq = rmsnorm(cq.reshape(b, s, C_HEADS, C_DIM), c_q_norm[l])
        o_c = memory_attention(cq, mk, mv)

        gates = jax.nn.sigmoid(h @ w_gate[l] + b_gate[l]).reshape(b, s, N_BRANCH, d)
        branches = jnp.stack([o_a, o_b, o_c], axis=2)
        y = jnp.einsum('bsnc,ncd,bsnd->bsd', branches, w_branch[l], gates)
        x = x + y @ w_out[l]

        x = x + 0.5 * swiglu(rmsnorm(x, ffn2_norm[l]), ffn2_wg[l], ffn2_wu[l], ffn2_wd[l])
        x = rmsnorm(x, final_norm[l])
    return x
```

```cpp
#include <hip/hip_runtime.h>
#include <cstdio>
#include <cstdint>
#include <cmath>
#include <type_traits>
namespace pg8 {
#define PG8_LAS __attribute__((address_space(3)))
typedef unsigned short bf16_t;
typedef short bf16x8 __attribute__((ext_vector_type(8)));
typedef float f32x4 __attribute__((ext_vector_type(4)));
typedef unsigned u32x4 __attribute__((ext_vector_type(4)));
constexpr int BM = 256, BK = 64, HALF = 128, HTB = HALF * BK * 2  , STAGE_BYTES = 8 * HTB, NXCD = 8;
#ifndef PG8_WGM
#define PG8_WGM 4
#endif
constexpr int WGM = PG8_WGM;

__host__ __device__ __forceinline__ int lds_byte(int r, int c) { const int st = (r >> 4) * 2 + (c >> 5), rr = r & 15, cc = c & 31, ob = rr * 64 + cc * 2; return st * 1024 + (ob ^ (((ob >> 9) & 1) << 5)); }
__host__ __device__ __forceinline__ void stage_rc(int b, int& R, int& C) { const int st = b / 1024, sb = b % 1024, swz = sb ^ (((sb >> 9) & 1) << 5); R = (st >> 1) * 16 + swz / 64; C = (st & 1) * 32 + (swz % 64) / 2; }
__host__ __device__ __forceinline__ int perm32(int rho) { const int n = rho >> 4, i = rho & 15; return 8 * (i >> 2) + 4 * n + (i & 3); }

struct Unit { int pm, pn; };
struct Gemm { const bf16_t* A; const bf16_t* Bt; int M, N, K; };

struct StaticOrder {
    int nM, nN, nwg, G, c;
    __host__ __device__ void init(int M, int N, int G_, int c_) { nM = M / BM; nN = N / BM; nwg = nM * nN; G = G_; c = c_; }
    __host__ __device__ bool next(int i, Unit& u) const {
        const long L = (long)i * G + c; if (L >= nwg) return false;
        int wgid = (int)L; { const int q = nwg / NXCD, r = nwg % NXCD, xcd = wgid % NXCD, off = wgid / NXCD; wgid = (xcd < r ? xcd * (q + 1) : r * (q + 1) + (xcd - r) * q) + off; }
        const int nig = WGM * nN, gid = wgid / nig, fm = gid * WGM, gsz = (nM - fm) < WGM ? (nM - fm) : WGM;
        u.pm = fm + ((wgid % nig) % gsz); u.pn = (wgid % nig) / gsz; return true;
    }
    __device__ __forceinline__ void a_ready(const Unit&) const {}
    __device__ __forceinline__ void done(const Unit&) const {}
};

typedef float f32x2c __attribute__((ext_vector_type(2))); typedef __bf16 bf16x2c __attribute__((ext_vector_type(2)));
__device__ __forceinline__ unsigned cvt_pk_bf16(float lo, float hi) { f32x2c v = {lo, hi}; bf16x2c b = __builtin_convertvector(v, bf16x2c); return __builtin_bit_cast(unsigned, b); }
typedef float f32x2 __attribute__((ext_vector_type(2)));
template <class Epi, class Sched, bool ALIGN_EPI = false, bool SP2 = false>
__device__ __forceinline__ void gemm_phase(PG8_LAS unsigned char* lds, const Gemm g, const Sched& S, const Epi& E) {
    const int tid = threadIdx.x, wid = __builtin_amdgcn_readfirstlane(tid >> 6), lane = tid & 63, wr = wid >> 2, wc = wid & 3, fr = lane & 15, fq = lane >> 4;
    const int K = g.K, nt = K / BK;
    unsigned voffA[2], voffB[2];
#pragma unroll
    for (int i = 0; i < 2; ++i) { int R, C; stage_rc(tid * 16 + i * 8192, R, C); const int Rb = Epi::PERM ? ((R & ~31) + perm32(R & 31)) : R;
        voffA[i] = (unsigned)(R * K + C) * 2u; voffB[i] = (unsigned)(Rb * K + C) * 2u; }
    const size_t kstep = (size_t)(BK * 2);
    const size_t hstep = (size_t)HALF * K * 2;
    const size_t tstep = 2 * hstep;
    const unsigned ldsw = (unsigned)wid * 1024u;
    const int aoff = lds_byte(wr * 64 + fr, fq * 8), boff = lds_byte(wc * 32 + fr, fq * 8);
#define PG8_SA(b, h) (((b) * 2 + (h)) * HTB)
#define PG8_SB(b, h) ((4 + (b) * 2 + (h)) * HTB)
#define PG8_STAGE(bufoff, gbase, voff) do { _Pragma("unroll") for (int _i = 0; _i < 2; ++_i) \
        __builtin_amdgcn_global_load_lds((const unsigned*)((const char*)(gbase) + (voff)[_i]), (PG8_LAS unsigned*)(lds + (bufoff) + ldsw + _i * 8192), 16, 0, 0); } while (0)
#define PG8_LDA(dst, b, h) do { _Pragma("unroll") for (int m = 0; m < 4; ++m) _Pragma("unroll") for (int k = 0; k < 2; ++k) dst[m][k] = *(const PG8_LAS bf16x8*)(lds + PG8_SA(b, h) + aoff + m * 2048 + k * 1024); } while (0)
#define PG8_LDB(dst, b, h) do { _Pragma("unroll") for (int n = 0; n < 2; ++n) _Pragma("unroll") for (int k = 0; k < 2; ++k) dst[n][k] = *(const PG8_LAS bf16x8*)(lds + PG8_SB(b, h) + boff + n * 2048 + k * 1024); } while (0)
#define PG8_MMA(ai, bj, At, Bt) do { __builtin_amdgcn_s_setprio(1); _Pragma("unroll") for (int m = 0; m < 4; ++m) _Pragma("unroll") for (int n = 0; n < 2; ++n) _Pragma("unroll") for (int k = 0; k < 2; ++k) \
        acc[ai][bj][m][n] = __builtin_amdgcn_mfma_f32_16x16x32_bf16(Bt[n][k], At[m][k], acc[ai][bj][m][n], 0, 0, 0); __builtin_amdgcn_s_setprio(0); } while (0)
#define PG8_WAIT_V(n) asm volatile("s_waitcnt vmcnt(" #n ")" ::: "memory")
#define PG8_WAIT_L(n) asm volatile("s_waitcnt lgkmcnt(" #n ")" ::: "memory")
#define PG8_BAR __builtin_amdgcn_s_barrier()
#define PG8_SCHED __builtin_amdgcn_sched_barrier(0)
    Unit cur, nxt; int ui = 0;
    if (!S.next(0, cur)) return;
    f32x4 acc[2][2][4][2];
#pragma unroll
    for (int a = 0; a < 2; ++a)
#pragma unroll
        for (int b = 0; b < 2; ++b)
#pragma unroll
            for (int m = 0; m < 4; ++m)
#pragma unroll
                for (int n = 0; n < 2; ++n) acc[a][b][m][n] = (f32x4){0.f, 0.f, 0.f, 0.f};
    bf16x8 At[4][2], B0[2][2], B1[2][2];
    const char* cA = (const char*)g.A + (size_t)cur.pm * tstep; const char* cB = (const char*)g.Bt + (size_t)cur.pn * tstep;
    S.a_ready(cur); E.pre(cur, wr, fr);
    if constexpr (SP2) {
        PG8_STAGE(PG8_SB(0, 0), cB, voffB); PG8_STAGE(PG8_SB(0, 1), cB + hstep, voffB); PG8_STAGE(PG8_SA(0, 0), cA, voffA); PG8_STAGE(PG8_SA(0, 1), cA + hstep, voffA);
        if (wr == 1) PG8_BAR;
        PG8_WAIT_V(2); PG8_BAR;
        PG8_STAGE(PG8_SB(1, 0), cB + kstep, voffB); PG8_STAGE(PG8_SA(1, 0), cA + kstep, voffA); PG8_STAGE(PG8_SB(1, 1), cB + hstep + kstep, voffB);
        PG8_WAIT_V(6); PG8_BAR;
    } else {
        PG8_STAGE(PG8_SB(0, 0), cB, voffB); PG8_STAGE(PG8_SA(0, 0), cA, voffA); PG8_STAGE(PG8_SB(0, 1), cB + hstep, voffB); PG8_STAGE(PG8_SA(0, 1), cA + hstep, voffA);
        if (wr == 1) PG8_BAR;
        PG8_WAIT_V(4); PG8_BAR;
        PG8_STAGE(PG8_SB(1, 0), cB + kstep, voffB); PG8_STAGE(PG8_SA(1, 0), cA + kstep, voffA); PG8_STAGE(PG8_SB(1, 1), cB + hstep + kstep, voffB);
        PG8_WAIT_V(6); PG8_BAR;
    }
    for (;;) {
        const bool has_next = S.next(ui + 1, nxt);
        const char* nA = has_next ? (const char*)g.A + (size_t)nxt.pm * tstep : cA; const char* nB = has_next ? (const char*)g.Bt + (size_t)nxt.pn * tstep : cB;
        for (int t = 0; t < nt; t += 2) {
            const bool last = (t == nt - 2);
            const char* a1 = cA + (size_t)(t + 1) * kstep;
            const char* a2 = last ? nA : cA + (size_t)(t + 2) * kstep; const char* b2 = last ? nB : cB + (size_t)(t + 2) * kstep;
            const char* a3 = a2 + kstep; const char* b3 = b2 + kstep;
            if (last && has_next) S.a_ready(nxt);
            if constexpr (SP2) {
            PG8_LDB(B0, 0, 0); PG8_LDB(B1, 0, 1); PG8_SCHED; PG8_LDA(At, 0, 0); PG8_STAGE(PG8_SA(1, 1), a1 + hstep, voffA);
            PG8_WAIT_V(8); PG8_WAIT_L(0); PG8_BAR; PG8_MMA(0, 0, At, B0); PG8_MMA(0, 1, At, B1); PG8_BAR; PG8_SCHED;
            PG8_LDA(At, 0, 1); PG8_STAGE(PG8_SB(0, 0), b2, voffB); PG8_STAGE(PG8_SB(0, 1), b2 + hstep, voffB); PG8_STAGE(PG8_SA(0, 0), a2, voffA);
            PG8_WAIT_V(8); PG8_WAIT_L(0); PG8_BAR; PG8_MMA(1, 0, At, B0); PG8_MMA(1, 1, At, B1); PG8_BAR; PG8_SCHED;
            PG8_LDB(B0, 1, 0); PG8_LDB(B1, 1, 1); PG8_SCHED; PG8_LDA(At, 1, 0); PG8_STAGE(PG8_SA(0, 1), a2 + hstep, voffA);
            PG8_WAIT_V(8); PG8_WAIT_L(0); PG8_BAR; PG8_MMA(0, 0, At, B0); PG8_MMA(0, 1, At, B1); PG8_BAR; PG8_SCHED;
            PG8_LDA(At, 1, 1); PG8_STAGE(PG8_SB(1, 0), b3, voffB); PG8_STAGE(PG8_SB(1, 1), b3 + hstep, voffB); PG8_STAGE(PG8_SA(1, 0), a3, voffA);
            PG8_WAIT_V(8); PG8_WAIT_L(0); PG8_BAR; PG8_MMA(1, 0, At, B0); PG8_MMA(1, 1, At, B1); PG8_BAR; PG8_SCHED;
            } else {
            PG8_LDB(B0, 0, 0); PG8_SCHED; PG8_LDA(At, 0, 0); PG8_STAGE(PG8_SA(1, 1), a1 + hstep, voffA);
            PG8_WAIT_L(8); PG8_BAR; PG8_WAIT_L(0); PG8_MMA(0, 0, At, B0); PG8_BAR; PG8_SCHED;
            PG8_LDB(B1, 0, 1); PG8_STAGE(PG8_SB(0, 0), b2, voffB);
            PG8_BAR; PG8_WAIT_L(0); PG8_MMA(0, 1, At, B1); PG8_BAR;
            PG8_LDA(At, 0, 1); PG8_STAGE(PG8_SA(0, 0), a2, voffA);
            PG8_BAR; PG8_WAIT_L(0); PG8_MMA(1, 0, At, B0); PG8_BAR; PG8_SCHED;
            PG8_STAGE(PG8_SB(0, 1), b2 + hstep, voffB);
            PG8_WAIT_V(6); PG8_BAR; PG8_MMA(1, 1, At, B1); PG8_BAR;
            PG8_LDB(B0, 1, 0); PG8_SCHED; PG8_LDA(At, 1, 0); PG8_STAGE(PG8_SA(0, 1), a2 + hstep, voffA);
            PG8_WAIT_L(8); PG8_BAR; PG8_WAIT_L(0); PG8_MMA(0, 0, At, B0); PG8_BAR; PG8_SCHED;
            PG8_LDB(B1, 1, 1); PG8_STAGE(PG8_SB(1, 0), b3, voffB);
            PG8_BAR; PG8_WAIT_L(0); PG8_MMA(0, 1, At, B1); PG8_BAR;
            PG8_LDA(At, 1, 1); PG8_STAGE(PG8_SA(1, 0), a3, voffA);
            PG8_BAR; PG8_WAIT_L(0); PG8_MMA(1, 0, At, B0); PG8_BAR; PG8_SCHED;
            PG8_STAGE(PG8_SB(1, 1), b3 + hstep, voffB);
            PG8_WAIT_V(6); PG8_BAR; PG8_MMA(1, 1, At, B1); PG8_BAR;
            }
        }
        if constexpr (ALIGN_EPI) { if (wr == 0) PG8_BAR; }
        if constexpr (!Epi::AFTER_DRAIN) { E(acc, cur, wr, wc, fr, fq); S.done(cur); }
        if (!has_next) break;
#pragma unroll
        for (int a = 0; a < 2; ++a)
#pragma unroll
            for (int b = 0; b < 2; ++b)
#pragma unroll
                for (int m = 0; m < 4; ++m)
#pragma unroll
                    for (int n = 0; n < 2; ++n) acc[a][b][m][n] = (f32x4){0.f, 0.f, 0.f, 0.f};
        cur = nxt; cA = nA; cB = nB; ++ui; E.pre(cur, wr, fr);
        if constexpr (ALIGN_EPI) { if (wr == 1) PG8_BAR; }
    }
    PG8_WAIT_V(0);
    if constexpr (!ALIGN_EPI) { if (wr == 0) PG8_BAR; }
    PG8_BAR;
    if constexpr (Epi::AFTER_DRAIN) { E.fused(acc, cur, wr, wc, fr, fq, lds, wid, lane); S.done(cur); }
#undef PG8_SA
#undef PG8_SB
#undef PG8_STAGE
#undef PG8_LDA
#undef PG8_LDB
#undef PG8_MMA
#undef PG8_WAIT_V
#undef PG8_WAIT_L
#undef PG8_BAR
#undef PG8_SCHED
}

template <class Epi, class Sched>
__device__ __forceinline__ void gemm_phase_vk(PG8_LAS unsigned char* lds, const Sched& S, const Epi& E) {
    const int tid = threadIdx.x, wid = __builtin_amdgcn_readfirstlane(tid >> 6), lane = tid & 63, wr = wid >> 2, wc = wid & 3, fr = lane & 15, fq = lane >> 4;
    int sR[2], sRb[2], sC[2];
#pragma unroll
    for (int i = 0; i < 2; ++i) { int R, C; stage_rc(tid * 16 + i * 8192, R, C); sR[i] = R; sRb[i] = Epi::PERM ? ((R & ~31) + perm32(R & 31)) : R; sC[i] = C; }
    const size_t kstep = (size_t)(BK * 2);
    const unsigned ldsw = (unsigned)wid * 1024u;
    const int aoff = lds_byte(wr * 64 + fr, fq * 8), boff = lds_byte(wc * 32 + fr, fq * 8);
#define PG8_SA(b, h) (((b) * 2 + (h)) * HTB)
#define PG8_SB(b, h) ((4 + (b) * 2 + (h)) * HTB)
#define PG8_STAGE(bufoff, gbase, voff) do { _Pragma("unroll") for (int _i = 0; _i < 2; ++_i) \
        __builtin_amdgcn_global_load_lds((const unsigned*)((const char*)(gbase) + (voff)[_i]), (PG8_LAS unsigned*)(lds + (bufoff) + ldsw + _i * 8192), 16, 0, 0); } while (0)
#define PG8_LDA(dst, b, h) do { _Pragma("unroll") for (int m = 0; m < 4; ++m) _Pragma("unroll") for (int k = 0; k < 2; ++k) dst[m][k] = *(const PG8_LAS bf16x8*)(lds + PG8_SA(b, h) + aoff + m * 2048 + k * 1024); } while (0)
#define PG8_LDB(dst, b, h) do { _Pragma("unroll") for (int n = 0; n < 2; ++n) _Pragma("unroll") for (int k = 0; k < 2; ++k) dst[n][k] = *(const PG8_LAS bf16x8*)(lds + PG8_SB(b, h) + boff + n * 2048 + k * 1024); } while (0)
#define PG8_MMA(ai, bj, At, Bt) do { __builtin_amdgcn_s_setprio(1); _Pragma("unroll") for (int m = 0; m < 4; ++m) _Pragma("unroll") for (int n = 0; n < 2; ++n) _Pragma("unroll") for (int k = 0; k < 2; ++k) \
        acc[ai][bj][m][n] = __builtin_amdgcn_mfma_f32_16x16x32_bf16(Bt[n][k], At[m][k], acc[ai][bj][m][n], 0, 0, 0); __builtin_amdgcn_s_setprio(0); } while (0)
#define PG8_WAIT_V(n) asm volatile("s_waitcnt vmcnt(" #n ")" ::: "memory")
#define PG8_WAIT_L(n) asm volatile("s_waitcnt lgkmcnt(" #n ")" ::: "memory")
#define PG8_BAR __builtin_amdgcn_s_barrier()
#define PG8_SCHED __builtin_amdgcn_sched_barrier(0)
#define PG8_VOFF(vA, vB, K_) do { _Pragma("unroll") for (int _i = 0; _i < 2; ++_i) { vA[_i] = (unsigned)(sR[_i] * (K_) + sC[_i]) * 2u; vB[_i] = (unsigned)(sRb[_i] * (K_) + sC[_i]) * 2u; } } while (0)
    Unit cur, nxt; int ui = 0;
    const char *cA, *cB, *nA, *nB; int Kc, Kn;
    if (!S.desc(0, cur, cA, cB, Kc)) return;
    f32x4 acc[2][2][4][2];
#pragma unroll
    for (int a = 0; a < 2; ++a)
#pragma unroll
        for (int b = 0; b < 2; ++b)
#pragma unroll
            for (int m = 0; m < 4; ++m)
#pragma unroll
                for (int n = 0; n < 2; ++n) acc[a][b][m][n] = (f32x4){0.f, 0.f, 0.f, 0.f};
    bf16x8 At[4][2], B0[2][2], B1[2][2];
    unsigned voffA[2], voffB[2]; PG8_VOFF(voffA, voffB, Kc); E.pre(cur, wr, fr);
    size_t hstep = (size_t)HALF * Kc * 2;
    PG8_STAGE(PG8_SB(0, 0), cB, voffB); PG8_STAGE(PG8_SB(0, 1), cB + hstep, voffB); PG8_STAGE(PG8_SA(0, 0), cA, voffA); PG8_STAGE(PG8_SA(0, 1), cA + hstep, voffA);
    if (wr == 1) PG8_BAR;
    PG8_WAIT_V(2); PG8_BAR;
    PG8_STAGE(PG8_SB(1, 0), cB + kstep, voffB); PG8_STAGE(PG8_SA(1, 0), cA + kstep, voffA); PG8_STAGE(PG8_SB(1, 1), cB + hstep + kstep, voffB);
    PG8_WAIT_V(6); PG8_BAR;
    for (;;) {
        const bool has_next = S.desc(ui + 1, nxt, nA, nB, Kn);
        if (!has_next) { nA = cA; nB = cB; Kn = Kc; }
        unsigned voffAn[2], voffBn[2]; PG8_VOFF(voffAn, voffBn, Kn);
        const size_t hstepn = (size_t)HALF * Kn * 2;
        const int nt = Kc / BK;
        for (int t = 0; t < nt; t += 2) {
            const bool last = (t == nt - 2);
            const char* a1 = cA + (size_t)(t + 1) * kstep;
            const char* a2 = last ? nA : cA + (size_t)(t + 2) * kstep; const char* b2 = last ? nB : cB + (size_t)(t + 2) * kstep;
            const char* a3 = a2 + kstep; const char* b3 = b2 + kstep;
            unsigned vA2[2], vB2[2];
#pragma unroll
            for (int i = 0; i < 2; ++i) { vA2[i] = last ? voffAn[i] : voffA[i]; vB2[i] = last ? voffBn[i] : voffB[i]; }
            const size_t h2 = last ? hstepn : hstep;
            PG8_LDB(B0, 0, 0); PG8_LDB(B1, 0, 1); PG8_SCHED; PG8_LDA(At, 0, 0); PG8_STAGE(PG8_SA(1, 1), a1 + hstep, voffA);
            PG8_WAIT_V(8); PG8_WAIT_L(0); PG8_BAR; PG8_MMA(0, 0, At, B0); PG8_MMA(0, 1, At, B1); PG8_BAR; PG8_SCHED;
            PG8_LDA(At, 0, 1); PG8_STAGE(PG8_SB(0, 0), b2, vB2); PG8_STAGE(PG8_SB(0, 1), b2 + h2, vB2); PG8_STAGE(PG8_SA(0, 0), a2, vA2);
            PG8_WAIT_V(8); PG8_WAIT_L(0); PG8_BAR; PG8_MMA(1, 0, At, B0); PG8_MMA(1, 1, At, B1); PG8_BAR; PG8_SCHED;
            PG8_LDB(B0, 1, 0); PG8_LDB(B1, 1, 1); PG8_SCHED; PG8_LDA(At, 1, 0); PG8_STAGE(PG8_SA(0, 1), a2 + h2, vA2);
            PG8_WAIT_V(8); PG8_WAIT_L(0); PG8_BAR; PG8_MMA(0, 0, At, B0); PG8_MMA(0, 1, At, B1); PG8_BAR; PG8_SCHED;
            PG8_LDA(At, 1, 1); PG8_STAGE(PG8_SB(1, 0), b3, vB2); PG8_STAGE(PG8_SB(1, 1), b3 + h2, vB2); PG8_STAGE(PG8_SA(1, 0), a3, vA2);
            PG8_WAIT_V(8); PG8_WAIT_L(0); PG8_BAR; PG8_MMA(1, 0, At, B0); PG8_MMA(1, 1, At, B1); PG8_BAR; PG8_SCHED;
        }
        if (wr == 0) PG8_BAR;
        E(acc, cur, wr, wc, fr, fq);
        if (!has_next) break;
#pragma unroll
        for (int a = 0; a < 2; ++a)
#pragma unroll
            for (int b = 0; b < 2; ++b)
#pragma unroll
                for (int m = 0; m < 4; ++m)
#pragma unroll
                    for (int n = 0; n < 2; ++n) acc[a][b][m][n] = (f32x4){0.f, 0.f, 0.f, 0.f};
        cur = nxt; cA = nA; cB = nB; Kc = Kn; hstep = hstepn; ++ui; E.pre(cur, wr, fr);
#pragma unroll
        for (int i = 0; i < 2; ++i) { voffA[i] = voffAn[i]; voffB[i] = voffBn[i]; }
        if (wr == 1) PG8_BAR;
    }
    PG8_WAIT_V(0);
    PG8_BAR;
#undef PG8_VOFF
#undef PG8_SA
#undef PG8_SB
#undef PG8_STAGE
#undef PG8_LDA
#undef PG8_LDB
#undef PG8_MMA
#undef PG8_WAIT_V
#undef PG8_WAIT_L
#undef PG8_BAR
#undef PG8_SCHED
}
}
namespace pg8 {
#define ST16(p, v) (*(u32x4*)(p) = (v))
typedef unsigned u32x2 __attribute__((ext_vector_type(2)));
constexpr float RMS_EPS = 1e-6f;
constexpr float LOG2E = 1.4426950408889634f;
__device__ __forceinline__ float sigmoid_f(float x) { return __builtin_amdgcn_rcpf(1.f + __builtin_amdgcn_exp2f(-LOG2E * x)); }
__device__ __forceinline__ float rowscale_of(const float* ss, int row) { return __builtin_amdgcn_rsqf(ss[row] * (1.0f / 1024.0f) + RMS_EPS); }
__device__ __forceinline__ void load_rowscales(float (&rs)[8], const float* ss, int row0) {
#pragma unroll
    for (int j = 0; j < 8; ++j) rs[j] = ss ? ss[row0 + (j >> 2) * HALF + (j & 3) * 16] : 0.f;
}
__device__ __forceinline__ float rowscale_from(float ssv) { return __builtin_amdgcn_rsqf(ssv * (1.0f / 1024.0f) + RMS_EPS); }
__device__ __forceinline__ u32x4 pack8(const f32x4& a, const f32x4& b) { u32x4 w; w.x = cvt_pk_bf16(a[0], a[1]); w.y = cvt_pk_bf16(a[2], a[3]); w.z = cvt_pk_bf16(b[0], b[1]); w.w = cvt_pk_bf16(b[2], b[3]); return w; }

struct EpiUp {
    static constexpr bool PERM = true, AFTER_DRAIN = false;
    bf16_t* O; int ldc; const float* ss;
    mutable float rs[8];
    __device__ __forceinline__ void pre(const Unit& u, int wr, int fr) const { load_rowscales(rs, ss, u.pm * BM + wr * 64 + fr); }
    __device__ __forceinline__ void operator()(const f32x4 (&acc)[2][2][4][2], const Unit& u, int wr, int wc, int fr, int fq) const {
        const int row0 = u.pm * BM + wr * 64 + fr, col0 = u.pn * 128 + wc * 32 + 8 * fq;
#pragma unroll
        for (int ai = 0; ai < 2; ++ai)
#pragma unroll
            for (int m = 0; m < 4; ++m) { const int row = row0 + ai * HALF + m * 16;
                const float ir2 = ss ? rs[ai * 4 + m] * (1.0f / 1024.0f) + RMS_EPS : 1.f, c1 = -LOG2E * __builtin_amdgcn_rsqf(ir2);
                f32x4 v[2];
#pragma unroll
                for (int n = 0; n < 2; ++n) { const f32x4 t = acc[ai][0][m][n] * c1, p = acc[ai][0][m][n] * acc[ai][1][m][n]; f32x4 e, d;
#pragma unroll
                    for (int i = 0; i < 4; ++i) e[i] = __builtin_amdgcn_exp2f(t[i]);
                    d = e * ir2 + ir2;
#pragma unroll
                    for (int i = 0; i < 4; ++i) d[i] = __builtin_amdgcn_rcpf(d[i]);
                    v[n] = p * d; }
                ST16(O + (size_t)row * ldc + col0, pack8(v[0], v[1])); }
    }
};

__device__ __forceinline__ void unpack8(const u32x4& g, f32x4& a, f32x4& b) {
    a[0] = __uint_as_float(g.x << 16); a[1] = __uint_as_float(g.x & 0xffff0000u); a[2] = __uint_as_float(g.y << 16); a[3] = __uint_as_float(g.y & 0xffff0000u);
    b[0] = __uint_as_float(g.z << 16); b[1] = __uint_as_float(g.z & 0xffff0000u); b[2] = __uint_as_float(g.w << 16); b[3] = __uint_as_float(g.w & 0xffff0000u);
}
template <bool BASE_BF16> struct EpiDown {
    static constexpr bool PERM = true, AFTER_DRAIN = false;
    const void* base; bf16_t* xb; float* ss; float alpha;
    __device__ __forceinline__ void pre(const Unit&, int, int) const {}
    __device__ __forceinline__ void operator()(const f32x4 (&acc)[2][2][4][2], const Unit& u, int wr, int wc, int fr, int fq) const {
        const int row0 = u.pm * BM + wr * 64 + fr, col0 = u.pn * BM + wc * 32 + 8 * fq;
        float qs[8];
#pragma unroll
        for (int ai = 0; ai < 2; ++ai) {
            u32x4 bb[4][2]; f32x4 bf[4][2][2];
#pragma unroll
            for (int m = 0; m < 4; ++m)
#pragma unroll
                for (int bj = 0; bj < 2; ++bj) { const size_t off = (size_t)(row0 + ai * HALF + m * 16) * 1024 + col0 + bj * HALF;
                    if (BASE_BF16) bb[m][bj] = *(const u32x4*)((const bf16_t*)base + off);
                    else { bf[m][bj][0] = *(const f32x4*)((const float*)base + off); bf[m][bj][1] = *(const f32x4*)((const float*)base + off + 4); } }
#pragma unroll
            for (int m = 0; m < 4; ++m) { const size_t off = (size_t)(row0 + ai * HALF + m * 16) * 1024 + col0; float q = 0.f;
#pragma unroll
                for (int bj = 0; bj < 2; ++bj) { f32x4 b0, b1;
                    if (BASE_BF16) unpack8(bb[m][bj], b0, b1); else { b0 = bf[m][bj][0]; b1 = bf[m][bj][1]; }
                    const f32x4 v0 = b0 + acc[ai][bj][m][0] * alpha, v1 = b1 + acc[ai][bj][m][1] * alpha;
                    q += (v0[0] * v0[0] + v0[1] * v0[1]) + (v0[2] * v0[2] + v0[3] * v0[3]) + (v1[0] * v1[0] + v1[1] * v1[1]) + (v1[2] * v1[2] + v1[3] * v1[3]);
                    ST16(xb + off + bj * HALF, pack8(v0, v1)); }
                q += __shfl_xor(q, 16); q += __shfl_xor(q, 32); qs[ai * 4 + m] = q; }
            asm volatile("" ::: "memory"); }
        if (fq == 0) {
#pragma unroll
            for (int j = 0; j < 8; ++j) atomicAdd(ss + row0 + (j >> 2) * HALF + (j & 3) * 16, qs[j]); }
    }
};

template <int ACT  > struct EpiPlain {
    static constexpr bool PERM = true, AFTER_DRAIN = false;
    bf16_t* O; int ldc; const float* ss; const float* bias;
    mutable float rs[8];
    __device__ __forceinline__ void pre(const Unit& u, int wr, int fr) const { load_rowscales(rs, ss, u.pm * BM + wr * 64 + fr); }
    __device__ __forceinline__ void operator()(const f32x4 (&acc)[2][2][4][2], const Unit& u, int wr, int wc, int fr, int fq) const {
        const int row0 = u.pm * BM + wr * 64 + fr, col0 = u.pn * BM + wc * 32 + 8 * fq;
        f32x4 bv[2][2];
#pragma unroll
        for (int bj = 0; bj < 2; ++bj)
#pragma unroll
            for (int n = 0; n < 2; ++n) bv[bj][n] = bias ? *(const f32x4*)(bias + col0 + bj * HALF + 4 * n) : (f32x4){0.f, 0.f, 0.f, 0.f};
#pragma unroll
        for (int ai = 0; ai < 2; ++ai)
#pragma unroll
            for (int m = 0; m < 4; ++m) { const int row = row0 + ai * HALF + m * 16; const float r = ss ? rowscale_from(rs[ai * 4 + m]) : 1.f;
#pragma unroll
                for (int bj = 0; bj < 2; ++bj) { f32x4 v0 = acc[ai][bj][m][0] * r + bv[bj][0], v1 = acc[ai][bj][m][1] * r + bv[bj][1];
                    if (ACT == 1) {
#pragma unroll
                        for (int i = 0; i < 4; ++i) { v0[i] = sigmoid_f(v0[i]); v1[i] = sigmoid_f(v1[i]); } }
                    ST16(O + (size_t)row * ldc + col0 + bj * HALF, pack8(v0, v1)); } }
    }
};

struct EpiProj {
    static constexpr bool PERM = true, AFTER_DRAIN = false;
    bf16_t* big;
    const float* ss;
    const float* gtab;
    const float *cosT, *sinT;
    mutable float rs[8];
    __device__ __forceinline__ void pre(const Unit& u, int wr, int fr) const { load_rowscales(rs, ss, u.pm * BM + wr * 64 + fr); }
    __device__ __forceinline__ static size_t sec_off(int kind) {
        constexpr size_t S = (size_t)32768 * 512;
        return kind == 0 ? 0 : kind == 1 ? 3 * S : kind == 2 ? 4 * S : kind == 3 ? 1 * S : kind == 4 ? 5 * S : kind == 5 ? 6 * S : 2 * S;
    }
    __device__ __forceinline__ void operator()(const f32x4 (&acc)[2][2][4][2], const Unit& u, int wr, int wc, int fr, int fq) const {
        const int kind = u.pn >> 1, half = u.pn & 1;
        const int row0 = u.pm * BM + wr * 64 + fr;
        bf16_t* base = big + sec_off(kind);
        const bool normk = (kind == 0) | (kind == 1) | (kind == 3) | (kind == 4);
        if (!normk) {
            const int col0 = half * 256 + wc * 32 + 8 * fq;
#pragma unroll
            for (int ai = 0; ai < 2; ++ai)
#pragma unroll
                for (int m = 0; m < 4; ++m) { const int row = row0 + ai * HALF + m * 16; const float r = rowscale_from(rs[ai * 4 + m]);
#pragma unroll
                    for (int bj = 0; bj < 2; ++bj) ST16(base + (size_t)row * 512 + col0 + bj * HALF, pack8(acc[ai][bj][m][0] * r, acc[ai][bj][m][1] * r)); }
        } else {
            const float* gain = gtab + 64 * (kind - (kind >= 3 ? 1 : 0));
            f32x4 gv[2][2];
#pragma unroll
            for (int bj = 0; bj < 2; ++bj)
#pragma unroll
                for (int n = 0; n < 2; ++n) gv[bj][n] = *(const f32x4*)(gain + 32 * bj + 8 * fq + 4 * n);
            const int col0 = half * 256 + wc * 64 + 8 * fq;
            auto body = [&](auto ROPEC) { constexpr bool rope = decltype(ROPEC)::value;
#pragma unroll
                for (int ah = 0; ah < 4; ++ah) { const int ai = ah >> 1, m0 = (ah & 1) * 2; f32x4 cs[2][2][2];
                    if (rope) {
#pragma unroll
                        for (int mm = 0; mm < 2; ++mm) { const int pos = (row0 + ai * HALF + (m0 + mm) * 16) & 4095;
#pragma unroll
                            for (int n = 0; n < 2; ++n) { cs[mm][n][0] = *(const f32x4*)(cosT + pos * 32 + 8 * fq + 4 * n); cs[mm][n][1] = *(const f32x4*)(sinT + pos * 32 + 8 * fq + 4 * n); } } }
#pragma unroll
                    for (int mm = 0; mm < 2; ++mm) { const int m = m0 + mm; const int row = row0 + ai * HALF + m * 16; const float r = rowscale_from(rs[ai * 4 + m]);
                        f32x4 v[2][2]; float q = 0.f;
#pragma unroll
                        for (int bj = 0; bj < 2; ++bj)
#pragma unroll
                            for (int n = 0; n < 2; ++n) { v[bj][n] = acc[ai][bj][m][n] * r; const f32x4 t = v[bj][n]; q += (t[0] * t[0] + t[1] * t[1]) + (t[2] * t[2] + t[3] * t[3]); }
                        q += __shfl_xor(q, 16); q += __shfl_xor(q, 32);
                        const float rn = __builtin_amdgcn_rsqf(q * (1.0f / 64.0f) + RMS_EPS);
#pragma unroll
                        for (int bj = 0; bj < 2; ++bj)
#pragma unroll
                            for (int n = 0; n < 2; ++n) v[bj][n] = v[bj][n] * rn * gv[bj][n];
                        if (rope) {
#pragma unroll
                            for (int n = 0; n < 2; ++n) { const f32x4 c = cs[mm][n][0], sn = cs[mm][n][1];
                                const f32x4 x1 = v[0][n], x2 = v[1][n]; v[0][n] = x1 * c - x2 * sn; v[1][n] = x2 * c + x1 * sn; } }
#pragma unroll
                        for (int bj = 0; bj < 2; ++bj) ST16(base + (size_t)row * 512 + col0 + 32 * bj, pack8(v[bj][0], v[bj][1])); }
                    asm volatile("" ::: "memory"); }
            };
            if (kind < 2) body(std::true_type{}); else body(std::false_type{});
        }
    }
};


__device__ __forceinline__ f32x4 dq4_u8(unsigned w) { f32x4 r; r[0] = (float)(w & 0xffu); r[1] = (float)((w >> 8) & 0xffu); r[2] = (float)((w >> 16) & 0xffu); r[3] = (float)(w >> 24); return r * (1.0f / 255.0f); }
struct EpiGB {
    static constexpr bool PERM = true, AFTER_DRAIN = false;
    const float* ss; const float* bias; bf16_t* y; u32x4* gsc; u32x4* ysc;
    mutable float rs[8];
    __device__ __forceinline__ void pre(const Unit& u, int wr, int fr) const { if (!(u.pm >> 9)) load_rowscales(rs, ss, (u.pm & 127) * BM + wr * 64 + fr); }
    __device__ __forceinline__ void operator()(const f32x4 (&acc)[2][2][4][2], const Unit& u, int wr, int wc, int fr, int fq) const {
        const int isB = u.pm >> 9, br = (u.pm >> 7) & 3, pm = u.pm & 127, pn = u.pn;
        const int row0 = pm * BM + wr * 64 + fr, col0 = pn * BM + wc * 32 + 8 * fq;
        __attribute__((address_space(1))) u32x4* gs = (__attribute__((address_space(1))) u32x4*)(gsc + threadIdx.x); asm volatile("" : "+v"(gs));
        if (!isB) {
            f32x4 bv[2][2];
#pragma unroll
            for (int bj = 0; bj < 2; ++bj)
#pragma unroll
                for (int n = 0; n < 2; ++n) bv[bj][n] = *(const f32x4*)(bias + br * 1024 + col0 + bj * HALF + 4 * n) * (-LOG2E) - 7.994353436858858f;
#pragma unroll
            for (int ai = 0; ai < 2; ++ai)
#pragma unroll
                for (int m = 0; m < 4; ++m) { const float c1 = -LOG2E * rowscale_from(rs[ai * 4 + m]); u32x4 w;
#pragma unroll
                    for (int bj = 0; bj < 2; ++bj)
#pragma unroll
                        for (int n = 0; n < 2; ++n) { const f32x4 t = acc[ai][bj][m][n] * c1 + bv[bj][n]; f32x4 e;
#pragma unroll
                            for (int i = 0; i < 4; ++i) e[i] = __builtin_amdgcn_exp2f(t[i]);
                            e = e + (1.0f / 255.0f);
                            unsigned q = 0;
#pragma unroll
                            for (int i = 0; i < 4; ++i) q = __builtin_amdgcn_cvt_pk_u8_f32(__builtin_amdgcn_rcpf(e[i]), i, q);
                            w[bj * 2 + n] = q; }
                    gs[(ai * 4 + m) * 512] = w; }
        } else {
            __attribute__((address_space(1))) u32x4* scb = (__attribute__((address_space(1))) u32x4*)(ysc + threadIdx.x); asm volatile("" : "+v"(scb));
            auto body = [&](auto BRC) { constexpr int BR = decltype(BRC)::value;
#pragma unroll
                for (int ai = 0; ai < 2; ++ai) { u32x4 gq[4], ys[4][2];
#pragma unroll
                    for (int m = 0; m < 4; ++m) gq[m] = gs[(ai * 4 + m) * 512];
                    if (BR > 0) {
#pragma unroll
                        for (int m = 0; m < 4; ++m)
#pragma unroll
                            for (int bj = 0; bj < 2; ++bj) ys[m][bj] = scb[((ai * 2 + bj) * 4 + m) * 512]; }
#pragma unroll
                    for (int m = 0; m < 4; ++m) { const int row = row0 + ai * HALF + m * 16;
#pragma unroll
                        for (int bj = 0; bj < 2; ++bj) { const f32x4 g0 = dq4_u8(bj == 0 ? gq[m].x : gq[m].z), g1 = dq4_u8(bj == 0 ? gq[m].y : gq[m].w);
                            f32x4 v0 = acc[ai][bj][m][0] * g0, v1 = acc[ai][bj][m][1] * g1;
                            if (BR > 0) { f32x4 y0, y1; unpack8(ys[m][bj], y0, y1); v0 += y0; v1 += y1; }
                            if (BR < 2) scb[((ai * 2 + bj) * 4 + m) * 512] = pack8(v0, v1);
                            else ST16(y + (size_t)row * 1024 + col0 + bj * HALF, pack8(v0, v1)); } }
                    asm volatile("" ::: "memory"); }
            };
            if (br == 0) body(std::integral_constant<int, 0>{}); else if (br == 1) body(std::integral_constant<int, 1>{}); else body(std::integral_constant<int, 2>{});
        }
    }
};
struct GateBranchOrder {
    StaticOrder so; const char *x1b, *wg, *oall, *wb;
    __device__ void init(int G, int c, const void* x1b_, const void* wg_, const void* oall_, const void* wb_) { so.init(32768, 1024, G, c); x1b = (const char*)x1b_; wg = (const char*)wg_; oall = (const char*)oall_; wb = (const char*)wb_; }
    __device__ bool desc(int i, Unit& u, const char*& A, const char*& B, int& K) const {
        const int q = i / 6, j = i - 6 * q, br = j >> 1, isB = j & 1; Unit t; if (!so.next(q, t)) return false;
        u.pm = t.pm + 128 * br + 512 * isB; u.pn = t.pn;
        if (!isB) { K = 1024; A = x1b + (size_t)t.pm * 256 * 1024 * 2; B = wg + (size_t)(br * 1024 + t.pn * 256) * 1024 * 2; }
        else { K = 512; A = oall + ((size_t)br * 32768 + (size_t)t.pm * 256) * 512 * 2; B = wb + (size_t)(br * 1024 + t.pn * 256) * 512 * 2; }
        return true;
    }
};
}
namespace att {
#define ALAS __attribute__((address_space(3)))
typedef unsigned short bf16_t;
typedef short bf16x8 __attribute__((ext_vector_type(8)));
typedef short s16x4 __attribute__((ext_vector_type(4)));
typedef float f32x16 __attribute__((ext_vector_type(16)));
typedef float f32x4 __attribute__((ext_vector_type(4)));
typedef unsigned u32x4 __attribute__((ext_vector_type(4)));
typedef unsigned u32x2 __attribute__((ext_vector_type(2)));
typedef float f32x2_t __attribute__((ext_vector_type(2)));
typedef __bf16 bf16x2_t __attribute__((ext_vector_type(2)));
typedef ALAS unsigned char* lptr;
typedef const ALAS unsigned char* lcptr;
constexpr float LOG2E = 1.4426950408889634f;
constexpr float RMS_EPS = 1e-6f;
__device__ __forceinline__ int crow(int r, int hi) { return (r & 3) + 8 * (r >> 2) + 4 * hi; }
__device__ __forceinline__ unsigned cvtpk(float lo, float hi) { f32x2_t v = {lo, hi}; bf16x2_t b = __builtin_convertvector(v, bf16x2_t); return __builtin_bit_cast(unsigned, b); }
__device__ __forceinline__ s16x4 vtr(lcptr p) { return __builtin_bit_cast(s16x4, __builtin_amdgcn_ds_read_tr16_b64_v4i16((ALAS s16x4*)p)); }
__device__ __forceinline__ float xhalf_max(float m) { auto rr = __builtin_amdgcn_permlane32_swap(__float_as_uint(m), __float_as_uint(m), false, false); return fmaxf(__uint_as_float(rr[0]), __uint_as_float(rr[1])); }
__device__ __forceinline__ float xhalf_sum(float m) { auto rr = __builtin_amdgcn_permlane32_swap(__float_as_uint(m), __float_as_uint(m), false, false); return __uint_as_float(rr[0]) + __uint_as_float(rr[1]); }
#define ATT_MFMA(a, b, c) __builtin_amdgcn_mfma_f32_32x32x16_bf16((a), (b), (c), 0, 0, 0)
#define ATT_BAR() do { asm volatile("s_waitcnt lgkmcnt(0)" ::: "memory"); __builtin_amdgcn_s_barrier(); asm volatile("" ::: "memory"); } while (0)

template <int KC, int VC> struct Geo {
    static constexpr int KPB = (KC + 8) * 2, VPB = (VC + 32) * 2, KBYTES = 64 * KPB, VBYTES = 64 * VPB, BUF = KBYTES + VBYTES;
    static constexpr int KCH = KC / 8, VCH = VC / 8;
    static constexpr int KN = 64 * KCH / 512, VN = 64 * VCH / 512;
};
template <int KC, int VC> struct Stage { u32x4 k[Geo<KC, VC>::KN]; u32x4 v[Geo<KC, VC>::VN]; };

template <int KC, int VC> __device__ __forceinline__ void stage_load(Stage<KC, VC>& st, const bf16_t* kthr, int kpitch, const bf16_t* vthr, int vpitch, int t) {
    typedef Geo<KC, VC> G;
#pragma unroll
    for (int i = 0; i < G::KN; ++i) st.k[i] = *(const u32x4*)(kthr + (size_t)(t * 64 + 32 * i) * kpitch);
#pragma unroll
    for (int i = 0; i < G::VN; ++i) st.v[i] = *(const u32x4*)(vthr + (size_t)(t * 64 + 32 * i) * vpitch);
}
template <int KC, int VC> __device__ __forceinline__ void stage_write(const Stage<KC, VC>& st, lptr kdst, lptr vdst) {
    typedef Geo<KC, VC> G;
#pragma unroll
    for (int i = 0; i < G::KN; ++i) *(ALAS u32x4*)(kdst + i * 32 * G::KPB) = st.k[i];
#pragma unroll
    for (int i = 0; i < G::VN; ++i) *(ALAS u32x4*)(vdst + i * 32 * G::VPB) = st.v[i];
}

constexpr float THR = 6.0f;
#define ATT_MX3(a, b, c) __builtin_fmaxf(__builtin_fmaxf((a), (b)), (c))
template <int NDK, int NDV, int KPB, int VPB, int MODE>
__device__ __forceinline__ void tile_compute(lcptr Kt, lcptr Vt, const bf16x8 (&qf)[NDK], f32x16 (&o)[NDV], float& mref, float& lrun, bool first,
                                             float rowscale, float cadd, const ALAS float* btab, int relbase, bool posbias, int lane, f32x16* cvec = nullptr) {
    const int r32 = lane & 31, hi = lane >> 5;
    lcptr kp = Kt + r32 * KPB + hi * 16;
    float c0 = -mref;
    if (MODE == 2) c0 = -mref * __builtin_amdgcn_rcpf(rowscale);
    if (MODE == 1) c0 = posbias ? -mref : cadd - mref;
    f32x16 p0, p1;
    if (MODE == 0) { p0 = *cvec; p1 = *cvec; }
    else {
#pragma unroll
        for (int r = 0; r < 16; ++r) { p0[r] = c0; p1[r] = c0; } }
#pragma unroll
    for (int d0 = 0; d0 < NDK; ++d0) {
        const bf16x8 a0 = *(const ALAS bf16x8*)(kp + d0 * 32), a1 = *(const ALAS bf16x8*)(kp + 32 * KPB + d0 * 32);
        p0 = ATT_MFMA(a0, qf[d0], p0); p1 = ATT_MFMA(a1, qf[d0], p1);
    }
    if (MODE == 2) {
#pragma unroll
        for (int r = 0; r < 16; ++r) { p0[r] *= rowscale; p1[r] *= rowscale; }
    }
    if (MODE == 1) {
        if (posbias) {
#pragma unroll
            for (int r = 0; r < 16; ++r) { const int kk = crow(r, hi); const int i0 = min(relbase - kk, 128) + 128, i1 = min(relbase - kk - 32, 128) + 128; p0[r] += btab[i0]; p1[r] += btab[i1]; }
        }
    }
    float ta = ATT_MX3(p0[0], p0[1], p1[0]), tb = ATT_MX3(p0[2], p0[3], p1[1]); ta = ATT_MX3(ta, p1[2], p1[3]);
#pragma unroll
    for (int r = 4; r < 16; r += 4) { ta = ATT_MX3(ta, p0[r], p0[r + 1]); tb = ATT_MX3(tb, p0[r + 2], p0[r + 3]); ta = ATT_MX3(ta, p1[r], p1[r + 1]); tb = ATT_MX3(tb, p1[r + 2], p1[r + 3]); }
    const float tm = xhalf_max(fmaxf(ta, tb));
    if (first || __builtin_amdgcn_ballot_w64(tm > THR) != 0ull) {
        const float d = first ? tm : fmaxf(tm, 0.f);
        mref += d;
        if (MODE == 0) {
#pragma unroll
            for (int r = 0; r < 16; ++r) (*cvec)[r] -= d; }
#pragma unroll
        for (int r = 0; r < 16; ++r) { p0[r] -= d; p1[r] -= d; }
        if (!first) { const float al = __builtin_amdgcn_exp2f(-d); lrun *= al;
#pragma unroll
            for (int dd = 0; dd < NDV; ++dd)
#pragma unroll
                for (int r = 0; r < 16; ++r) o[dd][r] *= al; }
    }
    float ls = 0.f;
#pragma unroll
    for (int r = 0; r < 16; ++r) { p0[r] = __builtin_amdgcn_exp2f(p0[r]); p1[r] = __builtin_amdgcn_exp2f(p1[r]); ls += p0[r] + p1[r]; }
    lrun += ls;
    bf16x8 pb[4];
#pragma unroll
    for (int ks = 0; ks < 4; ++ks) { u32x4 w;
        if (ks < 2) { const int b = 8 * (ks & 1); w.x = cvtpk(p0[b], p0[b + 1]); w.y = cvtpk(p0[b + 2], p0[b + 3]); w.z = cvtpk(p0[b + 4], p0[b + 5]); w.w = cvtpk(p0[b + 6], p0[b + 7]); }
        else { const int b = 8 * (ks & 1); w.x = cvtpk(p1[b], p1[b + 1]); w.y = cvtpk(p1[b + 2], p1[b + 3]); w.z = cvtpk(p1[b + 4], p1[b + 5]); w.w = cvtpk(p1[b + 6], p1[b + 7]); }
        pb[ks] = __builtin_bit_cast(bf16x8, w); }
    const int i16 = lane & 15, qq = i16 >> 2, pp = i16 & 3, blk = (lane >> 4) & 1;
    lcptr vp = Vt + (4 * hi + qq) * VPB + (16 * blk + 4 * pp) * 2;
#pragma unroll
    for (int d = 0; d < NDV; ++d)
#pragma unroll
        for (int ks = 0; ks < 4; ++ks) {
            const s16x4 lo = vtr(vp + ks * 16 * VPB + d * 64), h8 = vtr(vp + (ks * 16 + 8) * VPB + d * 64);
            const bf16x8 va = __builtin_shufflevector(lo, h8, 0, 1, 2, 3, 4, 5, 6, 7);
            o[d] = ATT_MFMA(va, pb[ks], o[d]);
        }
}

__device__ __forceinline__ void store_pair16(bf16_t* dst, int col, u32x2 a, u32x2 b, int hi) {
    auto rx = __builtin_amdgcn_permlane32_swap(a.x, b.x, false, false); auto ry = __builtin_amdgcn_permlane32_swap(a.y, b.y, false, false);
    u32x4 w; w.x = rx[0]; w.y = ry[0]; w.z = rx[1]; w.w = ry[1];
    *(u32x4*)(dst + col + 8 * hi) = w;
}
template <int NDV> __device__ __forceinline__ void store_o(const f32x16 (&o)[NDV], float inv, bf16_t* dst, int hi) {
#pragma unroll
    for (int d = 0; d < NDV; ++d)
#pragma unroll
        for (int g = 0; g < 4; g += 2) { u32x2 a, b;
            a.x = cvtpk(o[d][4 * g] * inv, o[d][4 * g + 1] * inv); a.y = cvtpk(o[d][4 * g + 2] * inv, o[d][4 * g + 3] * inv);
            b.x = cvtpk(o[d][4 * g + 4] * inv, o[d][4 * g + 5] * inv); b.y = cvtpk(o[d][4 * g + 6] * inv, o[d][4 * g + 7] * inv);
            store_pair16(dst, 32 * d + 8 * g, a, b, hi); }
}

template <int NQ> struct Pre { bf16x8 qf[NQ]; Stage<128, 128> st; };
__device__ __forceinline__ void preloadA(Pre<4>& P, int b, int h, int qb, const bf16_t* aq, const bf16_t* ak, const bf16_t* av, int tid) {
    asm volatile("" : "+v"(tid));
    const int lane = tid & 63, wave = __builtin_amdgcn_readfirstlane(tid >> 6), rb = wave & 3, comp = wave >> 2, r32 = lane & 31, hi = lane >> 5;
    const size_t rowbase = (size_t)b * 4096; const int q0 = qb * 128 + rb * 32;
#pragma unroll
    for (int d0 = 0; d0 < 4; ++d0) P.qf[d0] = *(const bf16x8*)(aq + (rowbase + q0 + r32) * 512 + h * 128 + comp * 64 + d0 * 16 + hi * 8);
    const int srow = tid >> 4, sch = tid & 15;
    stage_load<128, 128>(P.st, ak + rowbase * 512 + h * 128 + (size_t)srow * 512 + sch * 8, 512, av + rowbase * 512 + h * 128 + (size_t)srow * 512 + sch * 8, 512, 0);
}
__device__ __forceinline__ void unitA(int b, int h, int qb, const bf16_t* aq, const bf16_t* ak, const bf16_t* av, bf16_t* oa, const ALAS float* gsub, float lam, lptr lds, int tid,
                                      Pre<4>& P, bool has_next, int nb, int nh, int nqb) {
    typedef Geo<128, 128> G;
    asm volatile("" : "+v"(tid));
    const int lane = tid & 63, wave = __builtin_amdgcn_readfirstlane(tid >> 6), rb = wave & 3, comp = wave >> 2, r32 = lane & 31, hi = lane >> 5;
    const size_t rowbase = (size_t)b * 4096;
    const int q0 = qb * 128 + rb * 32;
    const bf16_t* Kg = ak + rowbase * 512 + h * 128; const bf16_t* Vg = av + rowbase * 512 + h * 128;
    bf16x8 (&qf)[4] = P.qf;
    f32x16 o[4];
#pragma unroll
    for (int d = 0; d < 4; ++d)
#pragma unroll
        for (int r = 0; r < 16; ++r) o[d][r] = 0.f;
    float mrun = 0.f, lrun = 0.f; bool first = true;
    f32x16 cv;
#pragma unroll
    for (int r = 0; r < 16; ++r) cv[r] = 0.f;
    const int nt = 2 * qb + 2, tlast = 2 * qb + (rb >> 1);
    Stage<128, 128>& st = P.st;
    const int srow = tid >> 4, sch = tid & 15;
    const bf16_t* kthr = Kg + (size_t)srow * 512 + sch * 8; const bf16_t* vthr = Vg + (size_t)srow * 512 + sch * 8;
    lptr kdst = lds + srow * G::KPB + sch * 16; lptr vdst = lds + G::KBYTES + srow * G::VPB + sch * 16;
    stage_write<128, 128>(st, kdst, vdst);
    if (nt > 1) stage_load<128, 128>(st, kthr, 512, vthr, 512, 1);
    ATT_BAR();
#pragma unroll 1
    for (int t = 0; t < nt; ++t) {
        const int bo = (t & 1) * G::BUF, bn = G::BUF - bo;
        lptr buf = lds + bo;
        if (t + 1 < nt) stage_write<128, 128>(st, kdst + bn, vdst + bn);
        if (t + 2 < nt) stage_load<128, 128>(st, kthr, 512, vthr, 512, t + 2);
        if (t <= tlast) { tile_compute<4, 4, G::KPB, G::VPB, 0>(buf + comp * 128, buf + G::KBYTES, qf, o, mrun, lrun, first, 1.f, 0.f, nullptr, 0, false, lane, &cv); first = false; }
        ATT_BAR();
    }
    if (has_next) preloadA(P, nb, nh, nqb, aq, ak, av, tid);
    const float inv = 1.0f / xhalf_sum(lrun);
    ALAS float* xch = (ALAS float*)lds + rb * 4096;
    if (comp == 1) {
        const float f = inv * lam;
#pragma unroll
        for (int d = 0; d < 4; ++d)
#pragma unroll
            for (int r = 0; r < 16; ++r) xch[(d * 16 + r) * 64 + lane] = o[d][r] * f;
    }
    ATT_BAR();
    if (comp == 0) {
        float ssq = 0.f;
#pragma unroll
        for (int d = 0; d < 4; ++d)
#pragma unroll
            for (int r = 0; r < 16; ++r) { const float v = o[d][r] * inv - xch[(d * 16 + r) * 64 + lane]; o[d][r] = v; ssq += v * v; }
        ssq = xhalf_sum(ssq);
        const float rn = __builtin_amdgcn_rsqf(ssq * (1.0f / 128.0f) + RMS_EPS) * 0.8f;
        bf16_t* dst = oa + (rowbase + q0 + r32) * 512 + h * 128;
#pragma unroll
        for (int d = 0; d < 4; ++d)
#pragma unroll
            for (int g = 0; g < 4; g += 2) { const f32x4 ga = *(const ALAS f32x4*)(gsub + 32 * d + 8 * g + 4 * hi), gb = *(const ALAS f32x4*)(gsub + 32 * d + 8 * g + 8 + 4 * hi);
                u32x2 a, b2;
                a.x = cvtpk(o[d][4 * g] * rn * ga[0], o[d][4 * g + 1] * rn * ga[1]); a.y = cvtpk(o[d][4 * g + 2] * rn * ga[2], o[d][4 * g + 3] * rn * ga[3]);
                b2.x = cvtpk(o[d][4 * g + 4] * rn * gb[0], o[d][4 * g + 5] * rn * gb[1]); b2.y = cvtpk(o[d][4 * g + 6] * rn * gb[2], o[d][4 * g + 7] * rn * gb[3]);
                store_pair16(dst, 32 * d + 8 * g, a, b2, hi); }
    }
    ATT_BAR();
}

__device__ __forceinline__ void setupB2(int hp, const float* relb, lptr lds, int tid) {
    ALAS float* btab2 = (ALAS float*)(lds + 2 * Geo<128, 128>::BUF);
    if (tid < 257) { btab2[tid] = relb[(2 * hp) * 257 + tid] * LOG2E; btab2[260 + tid] = relb[(2 * hp + 1) * 257 + tid] * LOG2E; }
}
__device__ __forceinline__ void preloadB2(Pre<4>& P, int b, int hp, int qb, const bf16_t* bq, const bf16_t* bk, const bf16_t* bv, int tid) {
    asm volatile("" : "+v"(tid));
    const int lane = tid & 63, wave = __builtin_amdgcn_readfirstlane(tid >> 6), rb = wave & 3, hh = wave >> 2, r32 = lane & 31, hi = lane >> 5, h = 2 * hp + hh;
    const size_t rowbase = (size_t)b * 4096; const int c0 = qb * 2, q0 = qb * 128 + rb * 32, j0 = c0 >= 8 ? 0 : 8 - c0;
#pragma unroll
    for (int d0 = 0; d0 < 4; ++d0) P.qf[d0] = *(const bf16x8*)(bq + (rowbase + q0 + r32) * 512 + h * 64 + d0 * 16 + hi * 8);
    const int srow = tid >> 4, sch = tid & 15; const size_t off = (rowbase + (size_t)(c0 - 8) * 64) * 512 + hp * 128 + (size_t)srow * 512 + sch * 8;
    stage_load<128, 128>(P.st, bk + off, 512, bv + off, 512, j0);
}
__device__ __forceinline__ void unitB2(int b, int hp, int qb, const bf16_t* bq, const bf16_t* bk, const bf16_t* bv, bf16_t* ob, const float* relb, lptr lds, int tid,
                                       Pre<4>& P, bool has_next, int nb, int nhp, int nqb) {
    typedef Geo<128, 128> G;
    asm volatile("" : "+v"(tid));
    const int lane = tid & 63, wave = __builtin_amdgcn_readfirstlane(tid >> 6), rb = wave & 3, hh = wave >> 2, r32 = lane & 31, hi = lane >> 5, wch = rb >> 1, h = 2 * hp + hh;
    const size_t rowbase = (size_t)b * 4096;
    const int c0 = qb * 2, q0 = qb * 128 + rb * 32;
    const ALAS float* btab = (const ALAS float*)(lds + 2 * G::BUF) + hh * 260;
    const bf16_t* Kg = bk + (rowbase + (size_t)(c0 - 8) * 64) * 512 + hp * 128; const bf16_t* Vg = bv + (rowbase + (size_t)(c0 - 8) * 64) * 512 + hp * 128;
    bf16x8 (&qf)[4] = P.qf;
    f32x16 o[2];
#pragma unroll
    for (int d = 0; d < 2; ++d)
#pragma unroll
        for (int r = 0; r < 16; ++r) o[d][r] = 0.f;
    float mrun = 0.f, lrun = 0.f; bool first = true;
    const int j0 = c0 >= 8 ? 0 : 8 - c0;
    const int qi = (rb & 1) * 32 + r32;
    Stage<128, 128>& st = P.st;
    const int srow = tid >> 4, sch = tid & 15;
    const bf16_t* kthr = Kg + (size_t)srow * 512 + sch * 8; const bf16_t* vthr = Vg + (size_t)srow * 512 + sch * 8;
    lptr kdst = lds + srow * G::KPB + sch * 16; lptr vdst = lds + G::KBYTES + srow * G::VPB + sch * 16;
    stage_write<128, 128>(st, kdst + (j0 & 1) * G::BUF, vdst + (j0 & 1) * G::BUF);
    if (j0 + 1 < 10) stage_load<128, 128>(st, kthr, 512, vthr, 512, j0 + 1);
    ATT_BAR();
#pragma unroll 1
    for (int t = j0; t < 10; ++t) {
        const int bo = (t & 1) * G::BUF, bn = G::BUF - bo;
        lptr buf = lds + bo;
        const int jb = t - wch;
        if (t + 1 < 10) stage_write<128, 128>(st, kdst + bn, vdst + bn);
        if (t + 2 < 10) stage_load<128, 128>(st, kthr, 512, vthr, 512, t + 2);
        if (jb >= 0 && jb <= 8) { tile_compute<4, 2, G::KPB, G::VPB, 1>(buf + hh * 128, buf + G::KBYTES + hh * 128, qf, o, mrun, lrun, first, 1.f, btab[256], btab, 64 * (8 - jb) + qi, jb >= 6, lane); first = false; }
        ATT_BAR();
    }
    if (has_next) preloadB2(P, nb, nhp, nqb, bq, bk, bv, tid);
    const float inv = 1.0f / xhalf_sum(lrun);
    store_o<2>(o, inv, ob + (rowbase + q0 + r32) * 512 + h * 64, hi);
}

__device__ __forceinline__ void unitC(int b, int h, int qb, const bf16_t* cq, const bf16_t* mkn, const bf16_t* mkv, bf16_t* oc, lptr lds, int tid) {
    typedef Geo<128, 128> G;
    asm volatile("" : "+v"(tid));
    const int lane = tid & 63, wave = __builtin_amdgcn_readfirstlane(tid >> 6), r32 = lane & 31, hi = lane >> 5;
    const size_t rowbase = (size_t)b * 4096;
    const int q0 = qb * 256 + wave * 32;
    const bf16_t* Kg = mkn + (size_t)b * 256 * 512 + h * 128; const bf16_t* Vg = mkv + (size_t)b * 256 * 1024 + 512 + h * 128;
    bf16x8 qf[8]; float ssq = 0.f;
#pragma unroll
    for (int d0 = 0; d0 < 8; ++d0) { qf[d0] = *(const bf16x8*)(cq + (rowbase + q0 + r32) * 512 + h * 128 + d0 * 16 + hi * 8);
#pragma unroll
        for (int j = 0; j < 8; ++j) { const float v = __uint_as_float(((unsigned)(unsigned short)qf[d0][j]) << 16); ssq += v * v; } }
    ssq = xhalf_sum(ssq);
    const float rq = __builtin_amdgcn_rsqf(ssq * (1.0f / 128.0f) + RMS_EPS);
    f32x16 o[4];
#pragma unroll
    for (int d = 0; d < 4; ++d)
#pragma unroll
        for (int r = 0; r < 16; ++r) o[d][r] = 0.f;
    float mrun = 0.f, lrun = 0.f; bool first = true;
    Stage<128, 128> st;
    const int srow = tid >> 4, sch = tid & 15;
    const bf16_t* kthr = Kg + (size_t)srow * 512 + sch * 8; const bf16_t* vthr = Vg + (size_t)srow * 1024 + sch * 8;
    lptr kdst = lds + srow * G::KPB + sch * 16; lptr vdst = lds + G::KBYTES + srow * G::VPB + sch * 16;
    stage_load<128, 128>(st, kthr, 512, vthr, 1024, 0);
    stage_write<128, 128>(st, kdst, vdst);
    stage_load<128, 128>(st, kthr, 512, vthr, 1024, 1);
    ATT_BAR();
#pragma unroll 1
    for (int t = 0; t < 4; ++t) {
        const int bo = (t & 1) * G::BUF, bn = G::BUF - bo;
        lptr buf = lds + bo;
        if (t + 1 < 4) stage_write<128, 128>(st, kdst + bn, vdst + bn);
        if (t + 2 < 4) stage_load<128, 128>(st, kthr, 512, vthr, 1024, t + 2);
        tile_compute<8, 4, G::KPB, G::VPB, 2>(buf, buf + G::KBYTES, qf, o, mrun, lrun, t == 0, rq, 0.f, nullptr, 0, false, lane);
        ATT_BAR();
    }
    const float inv = 1.0f / xhalf_sum(lrun);
    store_o<4>(o, inv, oc + (rowbase + q0 + r32) * 512 + h * 128, hi);
}

__device__ __forceinline__ void stageC_all(int b, int h, const bf16_t* mkn, const bf16_t* mkv, lptr lds, int tid) {
    typedef Geo<128, 128> G;
    asm volatile("" : "+v"(tid));
    const bf16_t* Kg = mkn + (size_t)b * 256 * 512 + h * 128; const bf16_t* Vg = mkv + (size_t)b * 256 * 1024 + 512 + h * 128;
    const int srow = tid >> 4, sch = tid & 15;
    const bf16_t* kthr = Kg + (size_t)srow * 512 + sch * 8; const bf16_t* vthr = Vg + (size_t)srow * 1024 + sch * 8;
    lptr kdst = lds + srow * G::KPB + sch * 16; lptr vdst = lds + G::KBYTES + srow * G::VPB + sch * 16;
    Stage<128, 128> sa, sb;
    stage_load<128, 128>(sa, kthr, 512, vthr, 1024, 0); stage_load<128, 128>(sb, kthr, 512, vthr, 1024, 1);
    stage_write<128, 128>(sa, kdst, vdst);                       stage_load<128, 128>(sa, kthr, 512, vthr, 1024, 2);
    stage_write<128, 128>(sb, kdst + G::BUF, vdst + G::BUF);     stage_load<128, 128>(sb, kthr, 512, vthr, 1024, 3);
    stage_write<128, 128>(sa, kdst + 2 * G::BUF, vdst + 2 * G::BUF);
    stage_write<128, 128>(sb, kdst + 3 * G::BUF, vdst + 3 * G::BUF);
    ATT_BAR();
}
__device__ __forceinline__ void unitC_res(int b, int h, int qb, const bf16_t* cq, bf16_t* oc, lptr lds, int tid) {
    typedef Geo<128, 128> G;
    asm volatile("" : "+v"(tid));
    const int lane = tid & 63, wave = __builtin_amdgcn_readfirstlane(tid >> 6), r32 = lane & 31, hi = lane >> 5;
    const size_t rowbase = (size_t)b * 4096;
    const int q0 = qb * 256 + wave * 32;
    bf16x8 qf[8]; float ssq = 0.f;
#pragma unroll
    for (int d0 = 0; d0 < 8; ++d0) { qf[d0] = *(const bf16x8*)(cq + (rowbase + q0 + r32) * 512 + h * 128 + d0 * 16 + hi * 8);
#pragma unroll
        for (int j = 0; j < 8; ++j) { const float v = __uint_as_float(((unsigned)(unsigned short)qf[d0][j]) << 16); ssq += v * v; } }
    ssq = xhalf_sum(ssq);
    const float rq = __builtin_amdgcn_rsqf(ssq * (1.0f / 128.0f) + RMS_EPS);
    f32x16 o[4];
#pragma unroll
    for (int d = 0; d < 4; ++d)
#pragma unroll
        for (int r = 0; r < 16; ++r) o[d][r] = 0.f;
    float mrun = 0.f, lrun = 0.f;
#pragma unroll 1
    for (int t = 0; t < 4; ++t) { lptr buf = lds + t * G::BUF;
        tile_compute<8, 4, G::KPB, G::VPB, 2>(buf, buf + G::KBYTES, qf, o, mrun, lrun, t == 0, rq, 0.f, nullptr, 0, false, lane); }
    const float inv = 1.0f / xhalf_sum(lrun);
    store_o<4>(o, inv, oc + (rowbase + q0 + r32) * 512 + h * 128, hi);
}

}
constexpr int NWAVES = 8;
#ifndef MK_N_LAUNCHES
#define MK_N_LAUNCHES 1
#endif
constexpr int N_PHASES = 10;
constexpr int N_LAUNCHES = MK_N_LAUNCHES;

constexpr int BATCH = 8, SEQ = 4096, DM = 1024, M = BATCH * SEQ, FF = 2816, NMEM = 256, MMEM = BATCH * NMEM, INC = 3584, GC = 3072;
constexpr float RMS_EPS = 1e-6f;
constexpr float LOG2E_F = 1.4426950408889634f;

constexpr size_t MiB = 1u << 20;
constexpr size_t WS_CTL = 0, CTL_ZERO_BYTES = 1 * MiB;
constexpr size_t WS_SS0 = 640 * 1024;
constexpr size_t WS_SS1 = 256 * 1024, WS_SS2 = 384 * 1024, WS_SS3 = 512 * 1024;
constexpr size_t WS_W1UP = 1 * MiB;
constexpr size_t WS_W1DN = 12 * MiB;
constexpr size_t WS_W2UP = 18 * MiB;
constexpr size_t WS_W2DN = 29 * MiB;
constexpr size_t WS_WIN = 35 * MiB;
constexpr size_t WS_WG = 42 * MiB;
constexpr size_t WS_WB = 48 * MiB;
constexpr size_t WS_WO = 51 * MiB;
constexpr size_t WS_WM = 53 * MiB;
constexpr size_t WS_COS = 55 * MiB, WS_SIN = 55 * MiB + 512 * 1024;
constexpr size_t WS_MISC = 56 * MiB;
constexpr size_t WS_MEMN = 57 * MiB;
constexpr size_t WS_MKV = 61 * MiB;
constexpr size_t WS_MKN = 65 * MiB;
constexpr size_t WS_B1 = 68 * MiB;
constexpr size_t WS_BIG = 132 * MiB;
constexpr size_t WS_ACT1 = WS_BIG;
constexpr size_t WS_Q3 = WS_BIG;
constexpr size_t WS_GBSCR = WS_BIG + 96 * MiB;
constexpr size_t WS_X2B = WS_BIG;
constexpr size_t WS_ACT2 = WS_BIG + 64 * MiB;
constexpr size_t WS_X3B = WS_BIG + 240 * MiB;
constexpr size_t WS_END = WS_BIG + 352 * MiB;
static_assert(WS_END <= 512 * MiB, "d_ws map");
constexpr int CW_BAR = 4096, CW_MEMGRP = 8192, CW_RB = 8448;

constexpr int RING_BYTES = 131072, LDS_BYTES = 163840, LDSCTL_OFF = LDS_BYTES - 1024, MISC_OFF = LDSCTL_OFF + 320;

#define GAS __attribute__((address_space(1)))
#define LAS __attribute__((address_space(3)))
typedef unsigned short bf16;
typedef unsigned v4u __attribute__((ext_vector_type(4)));
typedef float f32x4 __attribute__((ext_vector_type(4)));
typedef GAS unsigned gu32;
#define RLX_AGENT __ATOMIC_RELAXED, __HIP_MEMORY_SCOPE_AGENT
#define LDS_WAIT() asm volatile("s_waitcnt lgkmcnt(0)" ::: "memory")
#define VM_WAIT() asm volatile("s_waitcnt vmcnt(0)" ::: "memory")
__device__ __forceinline__ unsigned f2bf(float f) { unsigned u = __builtin_bit_cast(unsigned, f); return (u + 0x7fffu + ((u >> 16) & 1u)) >> 16; }
__device__ __forceinline__ unsigned pk2(float lo, float hi) { return f2bf(lo) | (f2bf(hi) << 16); }
__device__ __forceinline__ float bf2f(unsigned short h) { return __uint_as_float(((unsigned)h) << 16); }
#define XB_TMO      128
#define XB_XCNT(j)  (256  + 64 * (j))
#define XB_XSUB(j)  (1280 + 64 * (j))
#define XB_XGEN(j)  (2304 + 64 * (j))
#define XB_TOP      3328
#define XB_TOPGEN   3392
#define XCD_BAR_WORDS 3456
#define XB_SPIN_CAP (1u << 18)

__device__ __forceinline__ unsigned xb_ld(unsigned* p)              { return __hip_atomic_load(p, __ATOMIC_RELAXED, __HIP_MEMORY_SCOPE_AGENT); }
__device__ __forceinline__ unsigned xb_add(unsigned* p, unsigned v) { return __hip_atomic_fetch_add(p, v, __ATOMIC_RELAXED, __HIP_MEMORY_SCOPE_AGENT); }
__device__ __forceinline__ unsigned xb_xcc_id() { return (unsigned)__builtin_amdgcn_s_getreg((3 << 11) | 20) & 0xFu; }
#define XB_SPIN(cond, bar) do { unsigned _sp = 0; while (cond) { __builtin_amdgcn_s_sleep(1); \
    if ((++_sp & 255u) == 0u) { if (xb_ld(&(bar)[XB_TMO])) break; if (_sp > XB_SPIN_CAP) { atomicAdd(&(bar)[XB_TMO], 1u); break; } } } } while (0)

struct XcdBarrier {
    unsigned* bar; unsigned x;
    volatile LAS unsigned* st;
};

__device__ __forceinline__ XcdBarrier xcd_barrier_post(unsigned* bar, volatile LAS unsigned* st) {
    XcdBarrier b; b.bar = bar; b.x = xb_xcc_id(); b.st = st;
    if (threadIdx.x == 0) (void)xb_add(&bar[XB_XCNT(b.x)], 1u);
    return b;
}
__device__ __forceinline__ void xcd_barrier_complete(unsigned* bar, unsigned x, unsigned& nloc, unsigned& nx) {
    const unsigned G = gridDim.x * gridDim.y * gridDim.z;
    unsigned sum, cnt, mine, sp = 0u;
    for (;;) {
        sum = 0u; cnt = 0u; mine = 0u;
#pragma unroll
        for (unsigned j = 0; j < 16; ++j) { const unsigned c = xb_ld(&bar[XB_XCNT(j)]); sum += c; cnt += (c > 0u) ? 1u : 0u; mine = (j == x) ? c : mine; }
        if (sum == G) break;
        __builtin_amdgcn_s_sleep(1);
        if ((++sp & 255u) == 0u) { if (xb_ld(&bar[XB_TMO])) break; if (sp > XB_SPIN_CAP) { atomicAdd(&bar[XB_TMO], 1u); break; } }
    }
    nloc = mine > 0u ? mine : 1u; nx = cnt > 0u ? cnt : 1u;
}

__device__ __forceinline__ void xcd_barrier(const XcdBarrier& b) {
    asm volatile("s_waitcnt vmcnt(0)" ::: "memory");
    __syncthreads();
    if (threadIdx.x == 0) {
        unsigned* bar = b.bar;
        __builtin_amdgcn_s_waitcnt(0);
        unsigned nloc = b.st[0], nx = b.st[1];
        if (nloc == 0u) { xcd_barrier_complete(bar, b.x, nloc, nx); b.st[0] = nloc; b.st[1] = nx; }
        const unsigned old = xb_add(&bar[XB_XSUB(b.x)], 1u);
        const unsigned gen = old / nloc;
        if (old + 1u == (gen + 1u) * nloc) {
            __builtin_amdgcn_fence(__ATOMIC_RELEASE, "agent");
            asm volatile("s_waitcnt vmcnt(0)" ::: "memory");
            const unsigned og = xb_add(&bar[XB_TOP], 1u);
            const unsigned tg = og / nx;
            if (og + 1u == (tg + 1u) * nx) xb_add(&bar[XB_TOPGEN], 1u);
            else XB_SPIN(xb_ld(&bar[XB_TOPGEN]) == tg, bar);
            __builtin_amdgcn_fence(__ATOMIC_ACQUIRE, "agent");
            xb_add(&bar[XB_XGEN(b.x)], 1u);
            asm volatile("s_waitcnt vmcnt(0)" ::: "memory");
        } else {
            XB_SPIN(xb_ld(&bar[XB_XGEN(b.x)]) == gen, bar);
            __builtin_amdgcn_fence(__ATOMIC_ACQUIRE, "agent");
            asm volatile("s_waitcnt vmcnt(0)" ::: "memory");
        }
    }
    __syncthreads();
}
__device__ __forceinline__ float wave_sum(float v) {
#pragma unroll
    for (int o = 1; o < 64; o <<= 1) v += __shfl_xor(v, o);
    return v;
}
__device__ __forceinline__ void p0_transpose_item(const float* W, int ldw, const float* gain, bf16* dst, int ldd, int k0, int n0, int drow0, LAS float* scr, int lane) {
    const int r8 = lane >> 3, c4 = lane & 7;
    f32x4 v[8]; float gk[8];
#pragma unroll
    for (int i = 0; i < 8; ++i) v[i] = *(const GAS f32x4*)(W + (size_t)(k0 + 8 * i + r8) * ldw + n0 + 4 * c4);
#pragma unroll
    for (int i = 0; i < 8; ++i) gk[i] = gain ? gain[k0 + 8 * i + r8] : 1.f;
#pragma unroll
    for (int i = 0; i < 8; ++i) { LAS float* d = scr + (8 * i + r8) * 33 + 4 * c4; d[0] = v[i].x * gk[i]; d[1] = v[i].y * gk[i]; d[2] = v[i].z * gk[i]; d[3] = v[i].w * gk[i]; }
    LDS_WAIT(); asm volatile("" ::: "memory");
    const int c = lane & 7;
#pragma unroll
    for (int j = 0; j < 4; ++j) { const int n = (lane >> 3) + 8 * j; const LAS float* s = scr + (8 * c) * 33 + n;
        v4u o; o.x = pk2(s[0 * 33], s[1 * 33]); o.y = pk2(s[2 * 33], s[3 * 33]); o.z = pk2(s[4 * 33], s[5 * 33]); o.w = pk2(s[6 * 33], s[7 * 33]);
        *(GAS v4u*)(dst + (size_t)(drow0 + n) * ldd + k0 + 8 * c) = o; }
    LDS_WAIT(); asm volatile("" ::: "memory");
}
__device__ __forceinline__ int map_up(int n0, int which) { return 256 * (n0 >> 7) + 128 * which + (n0 & 127); }
__device__ __forceinline__ int map_win(int n0) {
    const int kind = n0 >> 9, w = n0 & 511, half = w >> 8, t = w & 255;
    if (kind == 0 || kind == 1 || kind == 3 || kind == 4) { const int wc = t >> 6, bj = (t >> 5) & 1; return kind * 512 + half * 256 + 128 * bj + 32 * wc; }
    return n0;
}
__device__ __forceinline__ void rms_rows2_to_bf16(const float* x0, const float* x1, const float* g, bf16* o0, bf16* o1, int lane) {
    const GAS f32x4* xa = (const GAS f32x4*)x0 + lane; const GAS f32x4* xb = (const GAS f32x4*)x1 + lane; const GAS f32x4* gr = (const GAS f32x4*)g + lane;
    f32x4 va[4], vb[4]; float sa = 0.f, sb = 0.f;
#pragma unroll
    for (int j = 0; j < 4; ++j) { va[j] = xa[64 * j]; vb[j] = xb[64 * j]; }
#pragma unroll
    for (int j = 0; j < 4; ++j) { sa += (va[j].x * va[j].x + va[j].y * va[j].y) + (va[j].z * va[j].z + va[j].w * va[j].w); sb += (vb[j].x * vb[j].x + vb[j].y * vb[j].y) + (vb[j].z * vb[j].z + vb[j].w * vb[j].w); }
    const float ra = 1.0f / sqrtf(wave_sum(sa) * (1.0f / 1024.0f) + RMS_EPS), rb = 1.0f / sqrtf(wave_sum(sb) * (1.0f / 1024.0f) + RMS_EPS);
    GAS unsigned long long* pa = (GAS unsigned long long*)o0 + lane; GAS unsigned long long* pb = (GAS unsigned long long*)o1 + lane;
#pragma unroll
    for (int j = 0; j < 4; ++j) { const f32x4 gg = gr[64 * j];
        pa[64 * j] = (unsigned long long)pk2(va[j].x * ra * gg.x, va[j].y * ra * gg.y) | ((unsigned long long)pk2(va[j].z * ra * gg.z, va[j].w * ra * gg.w) << 32);
        pb[64 * j] = (unsigned long long)pk2(vb[j].x * rb * gg.x, vb[j].y * rb * gg.y) | ((unsigned long long)pk2(vb[j].z * rb * gg.z, vb[j].w * rb * gg.w) << 32); }
}

__device__ __forceinline__ void cast_rows2_to_bf16(const float* x0, const float* x1, bf16* o0, bf16* o1, float* s0, float* s1, int lane) {
    const GAS f32x4* xa = (const GAS f32x4*)x0 + lane; const GAS f32x4* xb = (const GAS f32x4*)x1 + lane;
    f32x4 va[4], vb[4]; float sa = 0.f, sb = 0.f;
#pragma unroll
    for (int j = 0; j < 4; ++j) { va[j] = xa[64 * j]; vb[j] = xb[64 * j]; }
    GAS unsigned long long* pa = (GAS unsigned long long*)o0 + lane; GAS unsigned long long* pb = (GAS unsigned long long*)o1 + lane;
#pragma unroll
    for (int j = 0; j < 4; ++j) { sa += (va[j].x * va[j].x + va[j].y * va[j].y) + (va[j].z * va[j].z + va[j].w * va[j].w); sb += (vb[j].x * vb[j].x + vb[j].y * vb[j].y) + (vb[j].z * vb[j].z + vb[j].w * vb[j].w);
        pa[64 * j] = (unsigned long long)pk2(va[j].x, va[j].y) | ((unsigned long long)pk2(va[j].z, va[j].w) << 32);
        pb[64 * j] = (unsigned long long)pk2(vb[j].x, vb[j].y) | ((unsigned long long)pk2(vb[j].z, vb[j].w) << 32); }
    sa = wave_sum(sa); sb = wave_sum(sb);
    if (lane == 0) { *s0 = sa; *s1 = sb; }
}

struct Args { const float* in[28]; float* out; unsigned char* ws; int ph_lo, ph_hi, li, pad; };
__device__ const float ROPE_INV[32] = {1.000000000e+00f, 7.498942614e-01f, 5.623413324e-01f, 4.216965139e-01f, 3.162277639e-01f, 2.371373773e-01f, 1.778279394e-01f, 1.333521307e-01f, 1.000000015e-01f, 7.498941571e-02f, 5.623413250e-02f, 4.216965288e-02f, 3.162277490e-02f, 2.371373773e-02f, 1.778279431e-02f, 1.333521493e-02f, 9.999999776e-03f, 7.498941850e-03f, 5.623413250e-03f, 4.216964822e-03f, 3.162277630e-03f, 2.371373586e-03f, 1.778279431e-03f, 1.333521446e-03f, 1.000000047e-03f, 7.498942432e-04f, 5.623413017e-04f, 4.216965172e-04f, 3.162277571e-04f, 2.371373703e-04f, 1.778279402e-04f, 1.333521504e-04f};

struct Frame {
    LAS unsigned char* lds; volatile LAS unsigned* MISC; gu32* ctl;
    int tid, wave, vcu, G;
};

__device__ __forceinline__ void p0_prologue(Frame& F, const Args& a) {
    int tid_ = F.tid; asm volatile("" : "+v"(tid_)); const int lane_ = tid_ & 63;
    unsigned char* ws = a.ws;
    LAS float* scr = (LAS float*)(F.lds + F.wave * 16384);
    const bool split = F.G == 256, member = split && (F.vcu & 7) == 0;
    const int gw = (!split ? F.vcu : member ? (F.vcu >> 3) : F.vcu - (F.vcu >> 3) - 1) * NWAVES + F.wave, NGW = (!split ? F.G : member ? 32 : 224) * NWAVES;
    const float* x = a.in[0]; const float* mem = a.in[1];
    constexpr int I_UP = 16 * 88, I_DN = 44 * 32, I_IN = 16 * 112, I_G = 16 * 96, I_B = 8 * 32, I_O = 16 * 32;
    constexpr int NITEMS = 2 * (2 * I_UP + I_DN) + I_IN + I_G + 3 * I_B + 2 * I_O;
    const int it_lo = member ? NITEMS - I_O : 0, it_hi = (split && !member) ? NITEMS - I_O : NITEMS;
    for (int it = it_lo + gw; it < it_hi; it += NGW) {
        int r = it;
#define TR_ITEM(cnt, W, Kd, Nd, gain, dstoff, ldd, MAP) if (r < (cnt)) { const int nblk = (Nd) / 32, kb = r / nblk, nb = r % nblk, n0 = 32 * nb; \
            p0_transpose_item((W), (Nd), (gain), (bf16*)(ws + (dstoff)), (ldd), 64 * kb, n0, (MAP), scr, lane_); continue; } r -= (cnt);
        TR_ITEM(I_UP, a.in[3], 1024, FF, a.in[2], WS_W1UP, 1024, map_up(n0, 0))
        TR_ITEM(I_UP, a.in[4], 1024, FF, a.in[2], WS_W1UP, 1024, map_up(n0, 1))
        TR_ITEM(I_DN, a.in[5], FF, 1024, nullptr, WS_W1DN, FF, n0)
        TR_ITEM(I_UP, a.in[24], 1024, FF, a.in[23], WS_W2UP, 1024, map_up(n0, 0))
        TR_ITEM(I_UP, a.in[25], 1024, FF, a.in[23], WS_W2UP, 1024, map_up(n0, 1))
        TR_ITEM(I_DN, a.in[26], FF, 1024, nullptr, WS_W2DN, FF, n0)
        TR_ITEM(I_IN, a.in[7], 1024, INC, a.in[6], WS_WIN, 1024, map_win(n0))
        TR_ITEM(I_G, a.in[19], 1024, GC, a.in[6], WS_WG, 1024, n0)
        TR_ITEM(I_B, a.in[21], 512, 1024, nullptr, WS_WB, 512, n0)
        TR_ITEM(I_B, a.in[21] + 512 * 1024, 512, 1024, nullptr, WS_WB, 512, 1024 + n0)
        TR_ITEM(I_B, a.in[21] + 2 * 512 * 1024, 512, 1024, nullptr, WS_WB, 512, 2048 + n0)
        TR_ITEM(I_O, a.in[22], 1024, 1024, nullptr, WS_WO, 1024, n0)
        TR_ITEM(I_O, a.in[16], 1024, 1024, nullptr, WS_WM, 1024, n0)
#undef TR_ITEM
    }
    if (!member) { float* ss0 = (float*)(ws + WS_SS0); bf16* xb = (bf16*)(ws + WS_B1);
      for (int m = gw; m < M / 4; m += NGW) {
          const GAS f32x4* xr[4]; f32x4 v[4][4]; float sq[4];
#pragma unroll
          for (int q = 0; q < 4; ++q) { xr[q] = (const GAS f32x4*)(x + (size_t)(m + q * (M / 4)) * DM) + lane_;
#pragma unroll
              for (int j = 0; j < 4; ++j) v[q][j] = xr[q][64 * j]; }
#pragma unroll
          for (int q = 0; q < 4; ++q) { GAS unsigned long long* po = (GAS unsigned long long*)(xb + (size_t)(m + q * (M / 4)) * DM) + lane_; float s = 0.f;
#pragma unroll
              for (int j = 0; j < 4; ++j) { const f32x4 t = v[q][j]; s += (t.x * t.x + t.y * t.y) + (t.z * t.z + t.w * t.w);
                  po[64 * j] = (unsigned long long)pk2(t.x, t.y) | ((unsigned long long)pk2(t.z, t.w) << 32); }
              sq[q] = wave_sum(s); }
          if (lane_ == 0) {
#pragma unroll
              for (int q = 0; q < 4; ++q) ss0[m + q * (M / 4)] = sq[q]; } } }
    if (!split || member) for (int m = gw; m < MMEM / 2; m += NGW) rms_rows2_to_bf16(mem + (size_t)m * DM, mem + (size_t)(m + MMEM / 2) * DM, a.in[15], (bf16*)(ws + WS_MEMN) + (size_t)m * DM, (bf16*)(ws + WS_MEMN) + (size_t)(m + MMEM / 2) * DM, lane_);
    if (member) {
        unsigned* bar = (unsigned*)(F.ctl + CW_BAR); unsigned* cnt = (unsigned*)(F.ctl + CW_MEMGRP);
        asm volatile("s_waitcnt vmcnt(0)" ::: "memory");
        __syncthreads();
        if (F.tid == 0) {
            __builtin_amdgcn_fence(__ATOMIC_RELEASE, "agent");
            asm volatile("s_waitcnt vmcnt(0)" ::: "memory");
            (void)xb_add(cnt, 1u);
            XB_SPIN(xb_ld(cnt) < 32u, bar);
            __builtin_amdgcn_fence(__ATOMIC_ACQUIRE, "agent");
            asm volatile("s_waitcnt vmcnt(0)" ::: "memory");
        }
        __syncthreads();
        const int bx = (int)blockIdx.x;
        pg8::Gemm g{(const pg8::bf16_t*)(ws + WS_MEMN), (const pg8::bf16_t*)(ws + WS_WM), MMEM, DM, DM}; pg8::StaticOrder S; S.init(MMEM, DM, 32, (bx >> 6) * 8 + (bx & 7));
        pg8::EpiPlain<0> E{(pg8::bf16_t*)(ws + WS_MKV), 1024, nullptr, nullptr};
        pg8::gemm_phase<pg8::EpiPlain<0>, pg8::StaticOrder, true, true>(F.lds, g, S, E);
    }
    if (!split || member) { float* cosT = (float*)(ws + WS_COS); float* sinT = (float*)(ws + WS_SIN);
      for (int idx = (split ? (F.vcu >> 3) : F.vcu) * 512 + F.tid; idx < SEQ * 32; idx += (split ? 32 : F.G) * 512) {
          const int pos = idx >> 5, j = idx & 31; const float ang = (float)pos * ROPE_INV[j];
          const double xd = (double)ang; const double kq = rint(xd * 0.15915494309189535); const double rr = xd - kq * 6.283185307179586476925; const double r2 = rr * rr;
          double cs = 1.0, sn = 1.0, tc = 1.0, ts = 1.0;
#pragma unroll
          for (int n = 1; n <= 14; ++n) { tc = -tc * r2 * (1.0 / (double)((2 * n - 1) * (2 * n))); ts = -ts * r2 * (1.0 / (double)((2 * n) * (2 * n + 1))); cs += tc; sn += ts; }
          cosT[idx] = (float)cs; sinT[idx] = (float)(sn * rr); } }
    if (blockIdx.x == 1 % F.G && F.tid < 256) { const int k = F.tid >> 6, d = F.tid & 63; const float* src = k == 0 ? a.in[8] : k == 1 ? a.in[9] : k == 2 ? a.in[12] : a.in[13];
        ((float*)(ws + WS_MISC))[64 + F.tid] = src[d] * ((k & 1) ? 1.0f : 0.125f * LOG2E_F); }
    if (blockIdx.x == 0 && F.wave == 0) { const float* lp = a.in[10];
        const float s01 = wave_sum(lp[lane_] * lp[64 + lane_]), s23 = wave_sum(lp[128 + lane_] * lp[192 + lane_]);
        if (lane_ == 0) ((float*)(ws + WS_MISC))[0] = expf(s01) - expf(s23) + 0.2f; }
}

__device__ __forceinline__ void p2_mknorm(Frame& F, const Args& a) {
    int tid_ = F.tid; asm volatile("" : "+v"(tid_)); const int lane_ = tid_ & 63;
    const bf16* mkv = (const bf16*)(a.ws + WS_MKV); bf16* mkn = (bf16*)(a.ws + WS_MKN);
    const float* gk = a.in[18]; const float* gq = a.in[17];
    const int gw = F.vcu * NWAVES + F.wave, NGW = F.G * NWAVES;
    const float sc = 0.08838834764831845f * LOG2E_F;
    for (int it = gw; it < MMEM * 4; it += NGW) { const int t = it >> 2, h = it & 3;
        const unsigned u = *(const unsigned*)(mkv + (size_t)t * 1024 + h * 128 + 2 * lane_);
        const float v0 = bf2f((unsigned short)(u & 0xffffu)), v1 = bf2f((unsigned short)(u >> 16));
        const float r = 1.0f / sqrtf(wave_sum(v0 * v0 + v1 * v1) * (1.0f / 128.0f) + RMS_EPS);
        const int d = 2 * lane_;
        *(unsigned*)(mkn + (size_t)t * 512 + h * 128 + d) = pk2(v0 * r * gk[d] * gq[d] * sc, v1 * r * gk[d + 1] * gq[d + 1] * sc); }
}

__device__ __forceinline__ void p9_final_norm(Frame& F, const Args& a) {
    int tid_ = F.tid; asm volatile("" : "+v"(tid_)); const int lane_ = tid_ & 63;
    const float* ss = (const float*)(a.ws + WS_SS3); const float* g = a.in[27]; float* out = a.out; const bf16* x3 = (const bf16*)(a.ws + WS_X3B);
    const int gw = F.vcu * NWAVES + F.wave, NGW = F.G * NWAVES;
    f32x4 gg[2][2];
#pragma unroll
    for (int j = 0; j < 2; ++j) { gg[j][0] = *(const GAS f32x4*)(g + 512 * j + 8 * lane_); gg[j][1] = *(const GAS f32x4*)(g + 512 * j + 8 * lane_ + 4); }
    for (int m = gw; m < M / 4; m += NGW) {
        v4u u[4][2]; float sv[4];
#pragma unroll
        for (int q = 0; q < 4; ++q) { sv[q] = ss[m + q * (M / 4)];
#pragma unroll
            for (int j = 0; j < 2; ++j) u[q][j] = *(const GAS v4u*)(x3 + (size_t)(m + q * (M / 4)) * DM + 512 * j + 8 * lane_); }
#pragma unroll
        for (int q = 0; q < 4; ++q) { const float r = 1.0f / sqrtf(sv[q] * (1.0f / 1024.0f) + RMS_EPS);
#pragma unroll
            for (int j = 0; j < 2; ++j) { const v4u w = u[q][j]; f32x4 v0, v1;
                v0[0] = __uint_as_float(w.x << 16); v0[1] = __uint_as_float(w.x & 0xffff0000u); v0[2] = __uint_as_float(w.y << 16); v0[3] = __uint_as_float(w.y & 0xffff0000u);
                v1[0] = __uint_as_float(w.z << 16); v1[1] = __uint_as_float(w.z & 0xffff0000u); v1[2] = __uint_as_float(w.w << 16); v1[3] = __uint_as_float(w.w & 0xffff0000u);
                GAS f32x4* o = (GAS f32x4*)(out + (size_t)(m + q * (M / 4)) * DM + 512 * j + 8 * lane_);
                o[0] = v0 * r * gg[j][0]; o[1] = v1 * r * gg[j][1]; } } }
}

namespace pg8 {
struct EpiFinal {
    static constexpr bool PERM = true, AFTER_DRAIN = false;
    const bf16_t* base; float* out; float* ss; const float* gain; unsigned* rbc; unsigned* bar; float alpha;
    __device__ __forceinline__ void pre(const Unit&, int, int) const {}
    __device__ __forceinline__ void operator()(const f32x4 (&acc)[2][2][4][2], const Unit& u, int wr, int wc, int fr, int fq) const {
        const int row0 = u.pm * BM + wr * 64 + fr, col0 = u.pn * BM + wc * 32 + 8 * fq;
        float qs[8];
#pragma unroll
        for (int ai = 0; ai < 2; ++ai) { u32x4 bb[4][2];
#pragma unroll
            for (int m = 0; m < 4; ++m)
#pragma unroll
                for (int bj = 0; bj < 2; ++bj) bb[m][bj] = *(const u32x4*)(base + (size_t)(row0 + ai * HALF + m * 16) * 1024 + col0 + bj * HALF);
#pragma unroll
            for (int m = 0; m < 4; ++m) { float q = 0.f;
#pragma unroll
                for (int bj = 0; bj < 2; ++bj) { f32x4 b0, b1; unpack8(bb[m][bj], b0, b1);
                    const f32x4 v0 = b0 + acc[ai][bj][m][0] * alpha, v1 = b1 + acc[ai][bj][m][1] * alpha;
                    q += (v0[0] * v0[0] + v0[1] * v0[1]) + (v0[2] * v0[2] + v0[3] * v0[3]) + (v1[0] * v1[0] + v1[1] * v1[1]) + (v1[2] * v1[2] + v1[3] * v1[3]); }
                q += __shfl_xor(q, 16); q += __shfl_xor(q, 32); qs[ai * 4 + m] = q; }
            asm volatile("" ::: "memory"); }
        if (fq == 0) {
#pragma unroll
            for (int j = 0; j < 8; ++j) { const float old = atomicAdd(ss + row0 + (j >> 2) * HALF + (j & 3) * 16, qs[j]); asm volatile("" :: "v"(old)); } }
        asm volatile("s_waitcnt vmcnt(0)" ::: "memory");
        __syncthreads();
        if (threadIdx.x == 0) { (void)xb_add(&rbc[u.pm], 1u); XB_SPIN(xb_ld(&rbc[u.pm]) < 4u, bar); }
        __syncthreads();
        f32x4 gv[2][2];
#pragma unroll
        for (int bj = 0; bj < 2; ++bj)
#pragma unroll
            for (int n = 0; n < 2; ++n) gv[bj][n] = *(const f32x4*)(gain + col0 + bj * HALF + 4 * n);
        float sv[8];
#pragma unroll
        for (int j = 0; j < 8; ++j) sv[j] = __hip_atomic_load(ss + row0 + (j >> 2) * HALF + (j & 3) * 16, __ATOMIC_RELAXED, __HIP_MEMORY_SCOPE_AGENT);
#pragma unroll
        for (int ai = 0; ai < 2; ++ai) { u32x4 bb[4][2];
#pragma unroll
            for (int m = 0; m < 4; ++m)
#pragma unroll
                for (int bj = 0; bj < 2; ++bj) bb[m][bj] = *(const u32x4*)(base + (size_t)(row0 + ai * HALF + m * 16) * 1024 + col0 + bj * HALF);
#pragma unroll
            for (int m = 0; m < 4; ++m) { const size_t off = (size_t)(row0 + ai * HALF + m * 16) * 1024 + col0;
                const float r = __builtin_amdgcn_rsqf(sv[ai * 4 + m] * (1.0f / 1024.0f) + RMS_EPS);
#pragma unroll
                for (int bj = 0; bj < 2; ++bj) { f32x4 b0, b1; unpack8(bb[m][bj], b0, b1);
                    const f32x4 v0 = (b0 + acc[ai][bj][m][0] * alpha) * r * gv[bj][0], v1 = (b1 + acc[ai][bj][m][1] * alpha) * r * gv[bj][1];
                    *(f32x4*)(out + off + bj * HALF) = v0; *(f32x4*)(out + off + bj * HALF + 4) = v1; } }
            asm volatile("" ::: "memory"); }
    }
};
}
typedef LAS float* ALAS_F;
__global__ void __launch_bounds__(NWAVES * 64, 2) layer_fwd(Args args) {
    extern __shared__ __attribute__((aligned(16))) unsigned char lds[];
    Frame F;
    F.lds = (LAS unsigned char*)lds;
    F.MISC = (volatile LAS unsigned*)(F.lds + MISC_OFF);
    F.tid = threadIdx.x; F.wave = __builtin_amdgcn_readfirstlane(F.tid >> 6);
    F.G = gridDim.x; { const int bx = blockIdx.x; F.vcu = (F.G % 8 == 0) ? (bx % 8) * (F.G / 8) + bx / 8 : bx; }
    unsigned char* ws = args.ws;
    F.ctl = (gu32*)(ws + WS_CTL);
    for (int u = F.tid; u < (LDS_BYTES - LDSCTL_OFF) / 4; u += NWAVES * 64) ((LAS unsigned*)(F.lds + LDSCTL_OFF))[u] = 0u;
    __syncthreads();
    XcdBarrier bar; bar.bar = (unsigned*)(F.ctl + CW_BAR); bar.x = 0; bar.st = nullptr;
    if (N_LAUNCHES == 1) bar = xcd_barrier_post((unsigned*)(F.ctl + CW_BAR), F.MISC + 8);
#define GRID_BAR() do { if (N_LAUNCHES == 1) xcd_barrier(bar); } while (0)
    const int lo = args.ph_lo, hi = args.ph_hi;
#define IN(k) (lo <= (k) && (k) < hi)
#define BOTH(k) (IN(k) && IN((k) + 1))
    bf16* const W1UP = (bf16*)(ws + WS_W1UP); bf16* const W1DN = (bf16*)(ws + WS_W1DN); bf16* const W2UP = (bf16*)(ws + WS_W2UP); bf16* const W2DN = (bf16*)(ws + WS_W2DN);
    bf16* const WIN = (bf16*)(ws + WS_WIN); bf16* const WG = (bf16*)(ws + WS_WG); bf16* const WB = (bf16*)(ws + WS_WB); bf16* const WO = (bf16*)(ws + WS_WO); bf16* const WM = (bf16*)(ws + WS_WM);
    bf16* const B1 = (bf16*)(ws + WS_B1); bf16* const BIG = (bf16*)(ws + WS_BIG);
    float* const SS1 = (float*)(ws + WS_SS1); float* const SS2 = (float*)(ws + WS_SS2); float* const SS3 = (float*)(ws + WS_SS3);
    constexpr size_t SEC = (size_t)M * 512;
    const int cid = (int)blockIdx.x;

    if (IN(0)) { p0_prologue(F, args); if (BOTH(0)) GRID_BAR(); }

    if (IN(1)) {
        { pg8::Gemm g{B1, W1UP, M, 2 * FF, DM}; pg8::StaticOrder S; S.init(M, 2 * FF, F.G, cid);
          pg8::EpiUp E{(bf16*)(ws + WS_ACT1), FF, (const float*)(ws + WS_SS0)};
          pg8::gemm_phase<pg8::EpiUp, pg8::StaticOrder, true, true>(F.lds, g, S, E); }
        if (F.G != 256) { pg8::Gemm g{(const bf16*)(ws + WS_MEMN), WM, MMEM, DM, DM}; pg8::StaticOrder S; S.init(MMEM, DM, F.G, cid);
          pg8::EpiPlain<0> E{(bf16*)(ws + WS_MKV), 1024, nullptr, nullptr};
          pg8::gemm_phase<pg8::EpiPlain<0>, pg8::StaticOrder, true, true>(F.lds, g, S, E); }
        if (BOTH(1)) GRID_BAR();
    }

    if (IN(2)) {
        p2_mknorm(F, args);
        pg8::Gemm g{(const bf16*)(ws + WS_ACT1), W1DN, M, DM, FF}; pg8::StaticOrder S; S.init(M, DM, F.G, cid);
        pg8::EpiDown<true> E{B1, B1, SS1, 0.5f};
        pg8::gemm_phase<pg8::EpiDown<true>, pg8::StaticOrder, true, true>(F.lds, g, S, E);
        if (BOTH(2)) GRID_BAR();
    }

    if (IN(3)) {
        pg8::Gemm g{B1, WIN, M, INC, DM}; pg8::StaticOrder S; S.init(M, INC, F.G, cid);
        pg8::EpiProj E{BIG, SS1, (const float*)(ws + WS_MISC) + 64, (const float*)(ws + WS_COS), (const float*)(ws + WS_SIN)};
        pg8::gemm_phase<pg8::EpiProj, pg8::StaticOrder, true, true>(F.lds, g, S, E);
        if (BOTH(3)) GRID_BAR();
    }

    if (IN(4)) {
        bf16* aq = BIG; bf16* bq = BIG + SEC; bf16* cq = BIG + 2 * SEC; const bf16* ak = BIG + 3 * SEC; const bf16* av = BIG + 4 * SEC; const bf16* bk = BIG + 5 * SEC; const bf16* bv = BIG + 6 * SEC;
        const float lam = ((const float*)(ws + WS_MISC))[0];
#define A_DEC(u, B_, H_, Q_) const int v##B_ = (u) & 255, i##B_ = (u) >> 8, c##B_ = v##B_ & 31; const int B_ = v##B_ >> 5, H_ = i##B_ & 3, Q_ = (i##B_ & 1) ? 31 - c##B_ : c##B_
#define B_DEC(u, B_, H_, Q_) const int v##B_ = (u) & 255, i##B_ = (u) >> 8, bhp##B_ = v##B_ >> 3; const int B_ = bhp##B_ >> 2, H_ = bhp##B_ & 3, Q_ = (v##B_ & 7) * 4 + i##B_
        { att::Pre<4> P;
          { ALAS_F gsub = (ALAS_F)(F.lds + 2 * 37888 + 2080); if (F.tid < 128) gsub[F.tid] = args.in[11][F.tid];
            if (F.vcu < 1024) { A_DEC(F.vcu, b0, h0, q0); att::preloadA(P, b0, h0, q0, aq, ak, av, F.tid); }
            for (int u = F.vcu; u < 1024; u += F.G) { A_DEC(u, bc, hc, qc); A_DEC(u + F.G, bn, hn, qn);
                att::unitA(bc, hc, qc, aq, ak, av, aq, gsub, lam, F.lds, F.tid, P, u + F.G < 1024, bn, hn, qn); } }
          att::setupB2(((F.vcu & 255) >> 3) & 3, args.in[14], F.lds, F.tid);
          if (F.vcu < 1024) { B_DEC(F.vcu, b1, h1, q1); att::preloadB2(P, b1, h1, q1, bq, bk, bv, F.tid); }
          for (int u = F.vcu; u < 1024; u += F.G) { B_DEC(u, bc, hc, qc); B_DEC(u + F.G, bn, hn, qn);
              if (F.G != 256) { asm volatile("s_waitcnt lgkmcnt(0)" ::: "memory"); __builtin_amdgcn_s_barrier(); att::setupB2(hc, args.in[14], F.lds, F.tid); }
              att::unitB2(bc, hc, qc, bq, bk, bv, bq, args.in[14], F.lds, F.tid, P, u + F.G < 1024, bn, hn, qn); } }
#undef A_DEC
#undef B_DEC
        if (F.G == 256) { const int bh = F.vcu >> 3;
            att::stageC_all(bh >> 2, bh & 3, (const bf16*)(ws + WS_MKN), (const bf16*)(ws + WS_MKV), F.lds, F.tid);
            for (int i = 0; i < 2; ++i) att::unitC_res(bh >> 2, bh & 3, (F.vcu & 7) * 2 + i, cq, cq, F.lds, F.tid);
        } else
        for (int u = F.vcu; u < 512; u += F.G) { const int v = u & 255, i = u >> 8, bh = v >> 3, qb = (v & 7) * 2 + i;
            att::unitC(bh >> 2, bh & 3, qb, cq, (const bf16*)(ws + WS_MKN), (const bf16*)(ws + WS_MKV), cq, F.lds, F.tid); }
        if (BOTH(4)) GRID_BAR();
    }

    if (IN(5)) {
        pg8::GateBranchOrder S; S.init(F.G, cid, B1, WG, BIG, WB);
        unsigned char* scr = ws + WS_GBSCR + (size_t)blockIdx.x * (192 * 1024);
        pg8::EpiGB E{SS1, args.in[20], (bf16*)args.out, (pg8::u32x4*)scr, (pg8::u32x4*)(scr + 64 * 1024)};
        pg8::gemm_phase_vk<pg8::EpiGB, pg8::GateBranchOrder>(F.lds, S, E);
        if (BOTH(5)) GRID_BAR();
    }

    if (IN(6)) {
        pg8::Gemm g{(const bf16*)args.out, WO, M, DM, DM}; pg8::StaticOrder S; S.init(M, DM, F.G, cid);
        pg8::EpiDown<true> E{B1, (bf16*)(ws + WS_X2B), SS2, 1.0f};
        pg8::gemm_phase<pg8::EpiDown<true>, pg8::StaticOrder, true, true>(F.lds, g, S, E);
        if (BOTH(6)) GRID_BAR();
    }

    if (IN(7)) {
        pg8::Gemm g{(const bf16*)(ws + WS_X2B), W2UP, M, 2 * FF, DM}; pg8::StaticOrder S; S.init(M, 2 * FF, F.G, cid);
        pg8::EpiUp E{(bf16*)(ws + WS_ACT2), FF, SS2};
        pg8::gemm_phase<pg8::EpiUp, pg8::StaticOrder, true, true>(F.lds, g, S, E);
        if (BOTH(7)) GRID_BAR();
    }

    if (IN(8)) {
        pg8::Gemm g{(const bf16*)(ws + WS_ACT2), W2DN, M, DM, FF}; pg8::StaticOrder S; S.init(M, DM, F.G, cid);
        if (N_LAUNCHES == 1 && F.G == 256) {
            pg8::EpiFinal E{(const bf16*)(ws + WS_X2B), args.out, SS3, args.in[27], (unsigned*)(F.ctl + CW_RB), (unsigned*)(F.ctl + CW_BAR), 0.5f};
            pg8::gemm_phase<pg8::EpiFinal, pg8::StaticOrder, true, true>(F.lds, g, S, E);
            return;
        }
        pg8::EpiDown<true> E{(const bf16*)(ws + WS_X2B), (bf16*)(ws + WS_X3B), SS3, 0.5f};
        pg8::gemm_phase<pg8::EpiDown<true>, pg8::StaticOrder, true, true>(F.lds, g, S, E);
        if (BOTH(8)) GRID_BAR();
    }

    if (IN(9)) p9_final_norm(F, args);
#undef IN
#undef BOTH
#undef GRID_BAR
}

extern "C" void kernel_launch(void* const* d_in, const int* in_sizes, int n_in, void* d_out, int out_size, void* d_ws, size_t ws_size, hipStream_t stream) {
    static int grid = 0;
    if (grid == 0) {
        if (n_in != 28 || in_sizes[0] != M * DM || out_size != M * DM || ws_size < WS_END) { fprintf(stderr, "kernel_launch: unexpected shapes (n_in %d, in0 %d, out %d, ws %zu)\n", n_in, n_in > 0 ? in_sizes[0] : -1, out_size, ws_size); grid = -1; return; }
        int dev = 0, cus = 0, per_cu = 0;
        if (hipGetDevice(&dev) != hipSuccess || hipDeviceGetAttribute(&cus, hipDeviceAttributeMultiprocessorCount, dev) != hipSuccess) { grid = -1; return; }
        if (hipFuncSetAttribute((const void*)layer_fwd, hipFuncAttributeMaxDynamicSharedMemorySize, LDS_BYTES) != hipSuccess) { fprintf(stderr, "kernel_launch: hipFuncSetAttribute failed\n"); grid = -1; return; }
        if (hipOccupancyMaxActiveBlocksPerMultiprocessor(&per_cu, (const void*)layer_fwd, NWAVES * 64, LDS_BYTES) != hipSuccess || per_cu < 1) { fprintf(stderr, "kernel_launch: occupancy query says %d blocks per CU\n", per_cu); (void)hipGetLastError(); grid = -1; return; }
        grid = cus;
    }
    if (grid < 0) return;
    if (hipMemsetAsync((char*)d_ws + WS_CTL, 0, CTL_ZERO_BYTES, stream) != hipSuccess) return;
    Args a{};
    for (int i = 0; i < 28; ++i) a.in[i] = (const float*)d_in[i];
    a.out = (float*)d_out; a.ws = (unsigned char*)d_ws;
    for (int li = 0; li < N_LAUNCHES; ++li) {
        a.ph_lo = (N_LAUNCHES == 1) ? 0 : li; a.ph_hi = (N_LAUNCHES == 1) ? N_PHASES : li + 1; a.li = li;
        hipLaunchKernelGGL(layer_fwd, dim3(grid), dim3(NWAVES * 64), LDS_BYTES, stream, a);
        const hipError_t le = hipPeekAtLastError();
        if (le != hipSuccess) { fprintf(stderr, "kernel_launch: launch %d failed: %s\n", li, hipGetErrorName(le)); break; }
    }
}
```

```cpp
#include <hip/hip_runtime.h>
#include <cstdio>
#include <cstdint>
#include <cmath>
#include <type_traits>
namespace pg8 {
#define PG8_LAS __attribute__((address_space(3)))
typedef unsigned short bf16_t;
typedef short bf16x8 __attribute__((ext_vector_type(8)));
typedef float f32x4 __attribute__((ext_vector_type(4)));
typedef unsigned u32x4 __attribute__((ext_vector_type(4)));
constexpr int BM = 256, BK = 64, HALF = 128, HTB = HALF * BK * 2  , STAGE_BYTES = 8 * HTB, NXCD = 8;
#ifndef PG8_WGM
#define PG8_WGM 4
#endif
constexpr int WGM = PG8_WGM;

__host__ __device__ __forceinline__ int lds_byte(int r, int c) { const int st = (r >> 4) * 2 + (c >> 5), rr = r & 15, cc = c & 31, ob = rr * 64 + cc * 2; return st * 1024 + (ob ^ (((ob >> 9) & 1) << 5)); }
__host__ __device__ __forceinline__ void stage_rc(int b, int& R, int& C) { const int st = b / 1024, sb = b % 1024, swz = sb ^ (((sb >> 9) & 1) << 5); R = (st >> 1) * 16 + swz / 64; C = (st & 1) * 32 + (swz % 64) / 2; }
__host__ __device__ __forceinline__ int perm32(int rho) { const int n = rho >> 4, i = rho & 15; return 8 * (i >> 2) + 4 * n + (i & 3); }

struct Unit { int pm, pn; };
struct Gemm { const bf16_t* A; const bf16_t* Bt; int M, N, K; };

struct StaticOrder {
    int nM, nN, nwg, G, c;
    __host__ __device__ void init(int M, int N, int G_, int c_) { nM = M / BM; nN = N / BM; nwg = nM * nN; G = G_; c = c_; }
    __host__ __device__ bool next(int i, Unit& u) const {
        const long L = (long)i * G + c; if (L >= nwg) return false;
        int wgid = (int)L; { const int q = nwg / NXCD, r = nwg % NXCD, xcd = wgid % NXCD, off = wgid / NXCD; wgid = (xcd < r ? xcd * (q + 1) : r * (q + 1) + (xcd - r) * q) + off; }
        const int nig = WGM * nN, gid = wgid / nig, fm = gid * WGM, gsz = (nM - fm) < WGM ? (nM - fm) : WGM;
        u.pm = fm + ((wgid % nig) % gsz); u.pn = (wgid % nig) / gsz; return true;
    }
    __device__ __forceinline__ void a_ready(const Unit&) const {}
    __device__ __forceinline__ void done(const Unit&) const {}
};

typedef float f32x2c __attribute__((ext_vector_type(2))); typedef __bf16 bf16x2c __attribute__((ext_vector_type(2)));
__device__ __forceinline__ unsigned cvt_pk_bf16(float lo, float hi) { f32x2c v = {lo, hi}; bf16x2c b = __builtin_convertvector(v, bf16x2c); return __builtin_bit_cast(unsigned, b); }
typedef float f32x2 __attribute__((ext_vector_type(2)));
template <class Epi, class Sched, bool ALIGN_EPI = false, bool SP2 = false>
__device__ __forceinline__ void gemm_phase(PG8_LAS unsigned char* lds, const Gemm g, const Sched& S, const Epi& E) {
    const int tid = threadIdx.x, wid = __builtin_amdgcn_readfirstlane(tid >> 6), lane = tid & 63, wr = wid >> 2, wc = wid & 3, fr = lane & 15, fq = lane >> 4;
    const int K = g.K, nt = K / BK;
    unsigned voffA[2], voffB[2];
#pragma unroll
    for (int i = 0; i < 2; ++i) { int R, C; stage_rc(tid * 16 + i * 8192, R, C); const int Rb = Epi::PERM ? ((R & ~31) + perm32(R & 31)) : R;
        voffA[i] = (unsigned)(R * K + C) * 2u; voffB[i] = (unsigned)(Rb * K + C) * 2u; }
    const size_t kstep = (size_t)(BK * 2);
    const size_t hstep = (size_t)HALF * K * 2;
    const size_t tstep = 2 * hstep;
    const unsigned ldsw = (unsigned)wid * 1024u;
    const int aoff = lds_byte(wr * 64 + fr, fq * 8), boff = lds_byte(wc * 32 + fr, fq * 8);
#define PG8_SA(b, h) (((b) * 2 + (h)) * HTB)
#define PG8_SB(b, h) ((4 + (b) * 2 + (h)) * HTB)
#define PG8_STAGE(bufoff, gbase, voff) do { _Pragma("unroll") for (int _i = 0; _i < 2; ++_i) \
        __builtin_amdgcn_global_load_lds((const unsigned*)((const char*)(gbase) + (voff)[_i]), (PG8_LAS unsigned*)(lds + (bufoff) + ldsw + _i * 8192), 16, 0, 0); } while (0)
#define PG8_LDA(dst, b, h) do { _Pragma("unroll") for (int m = 0; m < 4; ++m) _Pragma("unroll") for (int k = 0; k < 2; ++k) dst[m][k] = *(const PG8_LAS bf16x8*)(lds + PG8_SA(b, h) + aoff + m * 2048 + k * 1024); } while (0)
#define PG8_LDB(dst, b, h) do { _Pragma("unroll") for (int n = 0; n < 2; ++n) _Pragma("unroll") for (int k = 0; k < 2; ++k) dst[n][k] = *(const PG8_LAS bf16x8*)(lds + PG8_SB(b, h) + boff + n * 2048 + k * 1024); } while (0)
#define PG8_MMA(ai, bj, At, Bt) do { __builtin_amdgcn_s_setprio(1); _Pragma("unroll") for (int m = 0; m < 4; ++m) _Pragma("unroll") for (int n = 0; n < 2; ++n) _Pragma("unroll") for (int k = 0; k < 2; ++k) \
        acc[ai][bj][m][n] = __builtin_amdgcn_mfma_f32_16x16x32_bf16(Bt[n][k], At[m][k], acc[ai][bj][m][n], 0, 0, 0); __builtin_amdgcn_s_setprio(0); } while (0)
#define PG8_WAIT_V(n) asm volatile("s_waitcnt vmcnt(" #n ")" ::: "memory")
#define PG8_WAIT_L(n) asm volatile("s_waitcnt lgkmcnt(" #n ")" ::: "memory")
#define PG8_BAR __builtin_amdgcn_s_barrier()
#define PG8_SCHED __builtin_amdgcn_sched_barrier(0)
    Unit cur, nxt; int ui = 0;
    if (!S.next(0, cur)) return;
    f32x4 acc[2][2][4][2];
#pragma unroll
    for (int a = 0; a < 2; ++a)
#pragma unroll
        for (int b = 0; b < 2; ++b)
#pragma unroll
            for (int m = 0; m < 4; ++m)
#pragma unroll
                for (int n = 0; n < 2; ++n) acc[a][b][m][n] = (f32x4){0.f, 0.f, 0.f, 0.f};
    bf16x8 At[4][2], B0[2][2], B1[2][2];
    const char* cA = (const char*)g.A + (size_t)cur.pm * tstep; const char* cB = (const char*)g.Bt + (size_t)cur.pn * tstep;
    S.a_ready(cur); E.pre(cur, wr, fr);
    if constexpr (SP2) {
        PG8_STAGE(PG8_SB(0, 0), cB, voffB); PG8_STAGE(PG8_SB(0, 1), cB + hstep, voffB); PG8_STAGE(PG8_SA(0, 0), cA, voffA); PG8_STAGE(PG8_SA(0, 1), cA + hstep, voffA);
        if (wr == 1) PG8_BAR;
        PG8_WAIT_V(2); PG8_BAR;
        PG8_STAGE(PG8_SB(1, 0), cB + kstep, voffB); PG8_STAGE(PG8_SA(1, 0), cA + kstep, voffA); PG8_STAGE(PG8_SB(1, 1), cB + hstep + kstep, voffB);
        PG8_WAIT_V(6); PG8_BAR;
    } else {
        PG8_STAGE(PG8_SB(0, 0), cB, voffB); PG8_STAGE(PG8_SA(0, 0), cA, voffA); PG8_STAGE(PG8_SB(0, 1), cB + hstep, voffB); PG8_STAGE(PG8_SA(0, 1), cA + hstep, voffA);
        if (wr == 1) PG8_BAR;
        PG8_WAIT_V(4); PG8_BAR;
        PG8_STAGE(PG8_SB(1, 0), cB + kstep, voffB); PG8_STAGE(PG8_SA(1, 0), cA + kstep, voffA); PG8_STAGE(PG8_SB(1, 1), cB + hstep + kstep, voffB);
        PG8_WAIT_V(6); PG8_BAR;
    }
    for (;;) {
        const bool has_next = S.next(ui + 1, nxt);
        const char* nA = has_next ? (const char*)g.A + (size_t)nxt.pm * tstep : cA; const char* nB = has_next ? (const char*)g.Bt + (size_t)nxt.pn * tstep : cB;
        for (int t = 0; t < nt; t += 2) {
            const bool last = (t == nt - 2);
            const char* a1 = cA + (size_t)(t + 1) * kstep;
            const char* a2 = last ? nA : cA + (size_t)(t + 2) * kstep; const char* b2 = last ? nB : cB + (size_t)(t + 2) * kstep;
            const char* a3 = a2 + kstep; const char* b3 = b2 + kstep;
            if (last && has_next) S.a_ready(nxt);
            if constexpr (SP2) {
            PG8_LDB(B0, 0, 0); PG8_LDB(B1, 0, 1); PG8_SCHED; PG8_LDA(At, 0, 0); PG8_STAGE(PG8_SA(1, 1), a1 + hstep, voffA);
            PG8_WAIT_V(8); PG8_WAIT_L(0); PG8_BAR; PG8_MMA(0, 0, At, B0); PG8_MMA(0, 1, At, B1); PG8_BAR; PG8_SCHED;
            PG8_LDA(At, 0, 1); PG8_STAGE(PG8_SB(0, 0), b2, voffB); PG8_STAGE(PG8_SB(0, 1), b2 + hstep, voffB); PG8_STAGE(PG8_SA(0, 0), a2, voffA);
            PG8_WAIT_V(8); PG8_WAIT_L(0); PG8_BAR; PG8_MMA(1, 0, At, B0); PG8_MMA(1, 1, At, B1); PG8_BAR; PG8_SCHED;
            PG8_LDB(B0, 1, 0); PG8_LDB(B1, 1, 1); PG8_SCHED; PG8_LDA(At, 1, 0); PG8_STAGE(PG8_SA(0, 1), a2 + hstep, voffA);
            PG8_WAIT_V(8); PG8_WAIT_L(0); PG8_BAR; PG8_MMA(0, 0, At, B0); PG8_MMA(0, 1, At, B1); PG8_BAR; PG8_SCHED;
            PG8_LDA(At, 1, 1); PG8_STAGE(PG8_SB(1, 0), b3, voffB); PG8_STAGE(PG8_SB(1, 1), b3 + hstep, voffB); PG8_STAGE(PG8_SA(1, 0), a3, voffA);
            PG8_WAIT_V(8); PG8_WAIT_L(0); PG8_BAR; PG8_MMA(1, 0, At, B0); PG8_MMA(1, 1, At, B1); PG8_BAR; PG8_SCHED;
            } else {
            PG8_LDB(B0, 0, 0); PG8_SCHED; PG8_LDA(At, 0, 0); PG8_STAGE(PG8_SA(1, 1), a1 + hstep, voffA);
            PG8_WAIT_L(8); PG8_BAR; PG8_WAIT_L(0); PG8_MMA(0, 0, At, B0); PG8_BAR; PG8_SCHED;
            PG8_LDB(B1, 0, 1); PG8_STAGE(PG8_SB(0, 0), b2, voffB);
            PG8_BAR; PG8_WAIT_L(0); PG8_MMA(0, 1, At, B1); PG8_BAR;
            PG8_LDA(At, 0, 1); PG8_STAGE(PG8_SA(0, 0), a2, voffA);
            PG8_BAR; PG8_WAIT_L(0); PG8_MMA(1, 0, At, B0); PG8_BAR; PG8_SCHED;
            PG8_STAGE(PG8_SB(0, 1), b2 + hstep, voffB);
            PG8_WAIT_V(6); PG8_BAR; PG8_MMA(1, 1, At, B1); PG8_BAR;
            PG8_LDB(B0, 1, 0); PG8_SCHED; PG8_LDA(At, 1, 0); PG8_STAGE(PG8_SA(0, 1), a2 + hstep, voffA);
            PG8_WAIT_L(8); PG8_BAR; PG8_WAIT_L(0); PG8_MMA(0, 0, At, B0); PG8_BAR; PG8_SCHED;
            PG8_LDB(B1, 1, 1); PG8_STAGE(PG8_SB(1, 0), b3, voffB);
            PG8_BAR; PG8_WAIT_L(0); PG8_MMA(0, 1, At, B1); PG8_BAR;
            PG8_LDA(At, 1, 1); PG8_STAGE(PG8_SA(1, 0), a3, voffA);
            PG8_BAR; PG8_WAIT_L(0); PG8_MMA(1, 0, At, B0); PG8_BAR; PG8_SCHED;
            PG8_STAGE(PG8_SB(1, 1), b3 + hstep, voffB);
            PG8_WAIT_V(6); PG8_BAR; PG8_MMA(1, 1, At, B1); PG8_BAR;
            }
        }
        if constexpr (ALIGN_EPI) { if (wr == 0) PG8_BAR; }
        if constexpr (!Epi::AFTER_DRAIN) { E(acc, cur, wr, wc, fr, fq); S.done(cur); }
        if (!has_next) break;
#pragma unroll
        for (int a = 0; a < 2; ++a)
#pragma unroll
            for (int b = 0; b < 2; ++b)
#pragma unroll
                for (int m = 0; m < 4; ++m)
#pragma unroll
                    for (int n = 0; n < 2; ++n) acc[a][b][m][n] = (f32x4){0.f, 0.f, 0.f, 0.f};
        cur = nxt; cA = nA; cB = nB; ++ui; E.pre(cur, wr, fr);
        if constexpr (ALIGN_EPI) { if (wr == 1) PG8_BAR; }
    }
    PG8_WAIT_V(0);
    if constexpr (!ALIGN_EPI) { if (wr == 0) PG8_BAR; }
    PG8_BAR;
    if constexpr (Epi::AFTER_DRAIN) { E.fused(acc, cur, wr, wc, fr, fq, lds, wid, lane); S.done(cur); }
#undef PG8_SA
#undef PG8_SB
#undef PG8_STAGE
#undef PG8_LDA
#undef PG8_LDB
#undef PG8_MMA
#undef PG8_WAIT_V
#undef PG8_WAIT_L
#undef PG8_BAR
#undef PG8_SCHED
}

template <class Epi, class Sched>
__device__ __forceinline__ void gemm_phase_vk(PG8_LAS unsigned char* lds, const Sched& S, const Epi& E) {
    const int tid = threadIdx.x, wid = __builtin_amdgcn_readfirstlane(tid >> 6), lane = tid & 63, wr = wid >> 2, wc = wid & 3, fr = lane & 15, fq = lane >> 4;
    int sR[2], sRb[2], sC[2];
#pragma unroll
    for (int i = 0; i < 2; ++i) { int R, C; stage_rc(tid * 16 + i * 8192, R, C); sR[i] = R; sRb[i] = Epi::PERM ? ((R & ~31) + perm32(R & 31)) : R; sC[i] = C; }
    const size_t kstep = (size_t)(BK * 2);
    const unsigned ldsw = (unsigned)wid * 1024u;
    const int aoff = lds_byte(wr * 64 + fr, fq * 8), boff = lds_byte(wc * 32 + fr, fq * 8);
#define PG8_SA(b, h) (((b) * 2 + (h)) * HTB)
#define PG8_SB(b, h) ((4 + (b) * 2 + (h)) * HTB)
#define PG8_STAGE(bufoff, gbase, voff) do { _Pragma("unroll") for (int _i = 0; _i < 2; ++_i) \
        __builtin_amdgcn_global_load_lds((const unsigned*)((const char*)(gbase) + (voff)[_i]), (PG8_LAS unsigned*)(lds + (bufoff) + ldsw + _i * 8192), 16, 0, 0); } while (0)
#define PG8_LDA(dst, b, h) do { _Pragma("unroll") for (int m = 0; m < 4; ++m) _Pragma("unroll") for (int k = 0; k < 2; ++k) dst[m][k] = *(const PG8_LAS bf16x8*)(lds + PG8_SA(b, h) + aoff + m * 2048 + k * 1024); } while (0)
#define PG8_LDB(dst, b, h) do { _Pragma("unroll") for (int n = 0; n < 2; ++n) _Pragma("unroll") for (int k = 0; k < 2; ++k) dst[n][k] = *(const PG8_LAS bf16x8*)(lds + PG8_SB(b, h) + boff + n * 2048 + k * 1024); } while (0)
#define PG8_MMA(ai, bj, At, Bt) do { __builtin_amdgcn_s_setprio(1); _Pragma("unroll") for (int m = 0; m < 4; ++m) _Pragma("unroll") for (int n = 0; n < 2; ++n) _Pragma("unroll") for (int k = 0; k < 2; ++k) \
        acc[ai][bj][m][n] = __builtin_amdgcn_mfma_f32_16x16x32_bf16(Bt[n][k], At[m][k], acc[ai][bj][m][n], 0, 0, 0); __builtin_amdgcn_s_setprio(0); } while (0)
#define PG8_WAIT_V(n) asm volatile("s_waitcnt vmcnt(" #n ")" ::: "memory")
#define PG8_WAIT_L(n) asm volatile("s_waitcnt lgkmcnt(" #n ")" ::: "memory")
#define PG8_BAR __builtin_amdgcn_s_barrier()
#define PG8_SCHED __builtin_amdgcn_sched_barrier(0)
#define PG8_VOFF(vA, vB, K_) do { _Pragma("unroll") for (int _i = 0; _i < 2; ++_i) { vA[_i] = (unsigned)(sR[_i] * (K_) + sC[_i]) * 2u; vB[_i] = (unsigned)(sRb[_i] * (K_) + sC[_i]) * 2u; } } while (0)
    Unit cur, nxt; int ui = 0;
    const char *cA, *cB, *nA, *nB; int Kc, Kn;
    if (!S.desc(0, cur, cA, cB, Kc)) return;
    f32x4 acc[2][2][4][2];
#pragma unroll
    for (int a = 0; a < 2; ++a)
#pragma unroll
        for (int b = 0; b < 2; ++b)
#pragma unroll
            for (int m = 0; m < 4; ++m)
#pragma unroll
                for (int n = 0; n < 2; ++n) acc[a][b][m][n] = (f32x4){0.f, 0.f, 0.f, 0.f};
    bf16x8 At[4][2], B0[2][2], B1[2][2];
    unsigned voffA[2], voffB[2]; PG8_VOFF(voffA, voffB, Kc); E.pre(cur, wr, fr);
    size_t hstep = (size_t)HALF * Kc * 2;
    PG8_STAGE(PG8_SB(0, 0), cB, voffB); PG8_STAGE(PG8_SB(0, 1), cB + hstep, voffB); PG8_STAGE(PG8_SA(0, 0), cA, voffA); PG8_STAGE(PG8_SA(0, 1), cA + hstep, voffA);
    if (wr == 1) PG8_BAR;
    PG8_WAIT_V(2); PG8_BAR;
    PG8_STAGE(PG8_SB(1, 0), cB + kstep, voffB); PG8_STAGE(PG8_SA(1, 0), cA + kstep, voffA); PG8_STAGE(PG8_SB(1, 1), cB + hstep + kstep, voffB);
    PG8_WAIT_V(6); PG8_BAR;
    for (;;) {
        const bool has_next = S.desc(ui + 1, nxt, nA, nB, Kn);
        if (!has_next) { nA = cA; nB = cB; Kn = Kc; }
        unsigned voffAn[2], voffBn[2]; PG8_VOFF(voffAn, voffBn, Kn);
        const size_t hstepn = (size_t)HALF * Kn * 2;
        const int nt = Kc / BK;
        for (int t = 0; t < nt; t += 2) {
            const bool last = (t == nt - 2);
            const char* a1 = cA + (size_t)(t + 1) * kstep;
            const char* a2 = last ? nA : cA + (size_t)(t + 2) * kstep; const char* b2 = last ? nB : cB + (size_t)(t + 2) * kstep;
            const char* a3 = a2 + kstep; const char* b3 = b2 + kstep;
            unsigned vA2[2], vB2[2];
#pragma unroll
            for (int i = 0; i < 2; ++i) { vA2[i] = last ? voffAn[i] : voffA[i]; vB2[i] = last ? voffBn[i] : voffB[i]; }
            const size_t h2 = last ? hstepn : hstep;
            PG8_LDB(B0, 0, 0); PG8_LDB(B1, 0, 1); PG8_SCHED; PG8_LDA(At, 0, 0); PG8_STAGE(PG8_SA(1, 1), a1 + hstep, voffA);
            PG8_WAIT_V(8); PG8_WAIT_L(0); PG8_BAR; PG8_MMA(0, 0, At, B0); PG8_MMA(0, 1, At, B1); PG8_BAR; PG8_SCHED;
            PG8_LDA(At, 0, 1); PG8_STAGE(PG8_SB(0, 0), b2, vB2); PG8_STAGE(PG8_SB(0, 1), b2 + h2, vB2); PG8_STAGE(PG8_SA(0, 0), a2, vA2);
            PG8_WAIT_V(8); PG8_WAIT_L(0); PG8_BAR; PG8_MMA(1, 0, At, B0); PG8_MMA(1, 1, At, B1); PG8_BAR; PG8_SCHED;
            PG8_LDB(B0, 1, 0); PG8_LDB(B1, 1, 1); PG8_SCHED; PG8_LDA(At, 1, 0); PG8_STAGE(PG8_SA(0, 1), a2 + h2, vA2);
            PG8_WAIT_V(8); PG8_WAIT_L(0); PG8_BAR; PG8_MMA(0, 0, At, B0); PG8_MMA(0, 1, At, B1); PG8_BAR; PG8_SCHED;
            PG8_LDA(At, 1, 1); PG8_STAGE(PG8_SB(1, 0), b3, vB2); PG8_STAGE(PG8_SB(1, 1), b3 + h2, vB2); PG8_STAGE(PG8_SA(1, 0), a3, vA2);
            PG8_WAIT_V(8); PG8_WAIT_L(0); PG8_BAR; PG8_MMA(1, 0, At, B0); PG8_MMA(1, 1, At, B1); PG8_BAR; PG8_SCHED;
        }
        if (wr == 0) PG8_BAR;
        E(acc, cur, wr, wc, fr, fq);
        if (!has_next) break;
#pragma unroll
        for (int a = 0; a < 2; ++a)
#pragma unroll
            for (int b = 0; b < 2; ++b)
#pragma unroll
                for (int m = 0; m < 4; ++m)
#pragma unroll
                    for (int n = 0; n < 2; ++n) acc[a][b][m][n] = (f32x4){0.f, 0.f, 0.f, 0.f};
        cur = nxt; cA = nA; cB = nB; Kc = Kn; hstep = hstepn; ++ui; E.pre(cur, wr, fr);
#pragma unroll
        for (int i = 0; i < 2; ++i) { voffA[i] = voffAn[i]; voffB[i] = voffBn[i]; }
        if (wr == 1) PG8_BAR;
    }
    PG8_WAIT_V(0);
    PG8_BAR;
#undef PG8_VOFF
#undef PG8_SA
#undef PG8_SB
#undef PG8_STAGE
#undef PG8_LDA
#undef PG8_LDB
#undef PG8_MMA
#undef PG8_WAIT_V
#undef PG8_WAIT_L
#undef PG8_BAR
#undef PG8_SCHED
}
}
namespace pg8 {
#define ST16(p, v) (*(u32x4*)(p) = (v))
typedef unsigned u32x2 __attribute__((ext_vector_type(2)));
constexpr float RMS_EPS = 1e-6f;
constexpr float LOG2E = 1.4426950408889634f;
__device__ __forceinline__ float sigmoid_f(float x) { return __builtin_amdgcn_rcpf(1.f + __builtin_amdgcn_exp2f(-LOG2E * x)); }
__device__ __forceinline__ float rowscale_of(const float* ss, int row) { return __builtin_amdgcn_rsqf(ss[row] * (1.0f / 1024.0f) + RMS_EPS); }
__device__ __forceinline__ void load_rowscales(float (&rs)[8], const float* ss, int row0) {
#pragma unroll
    for (int j = 0; j < 8; ++j) rs[j] = ss ? ss[row0 + (j >> 2) * HALF + (j & 3) * 16] : 0.f;
}
__device__ __forceinline__ float rowscale_from(float ssv) { return __builtin_amdgcn_rsqf(ssv * (1.0f / 1024.0f) + RMS_EPS); }
__device__ __forceinline__ u32x4 pack8(const f32x4& a, const f32x4& b) { u32x4 w; w.x = cvt_pk_bf16(a[0], a[1]); w.y = cvt_pk_bf16(a[2], a[3]); w.z = cvt_pk_bf16(b[0], b[1]); w.w = cvt_pk_bf16(b[2], b[3]); return w; }

struct EpiUp {
    static constexpr bool PERM = true, AFTER_DRAIN = false;
    bf16_t* O; int ldc; const float* ss;
    mutable float rs[8];
    __device__ __forceinline__ void pre(const Unit& u, int wr, int fr) const { load_rowscales(rs, ss, u.pm * BM + wr * 64 + fr); }
    __device__ __forceinline__ void operator()(const f32x4 (&acc)[2][2][4][2], const Unit& u, int wr, int wc, int fr, int fq) const {
        const int row0 = u.pm * BM + wr * 64 + fr, col0 = u.pn * 128 + wc * 32 + 8 * fq;
#pragma unroll
        for (int ai = 0; ai < 2; ++ai)
#pragma unroll
            for (int m = 0; m < 4; ++m) { const int row = row0 + ai * HALF + m * 16;
                const float ir2 = ss ? rs[ai * 4 + m] * (1.0f / 1024.0f) + RMS_EPS : 1.f, c1 = -LOG2E * __builtin_amdgcn_rsqf(ir2);
                f32x4 v[2];
#pragma unroll
                for (int n = 0; n < 2; ++n) { const f32x4 t = acc[ai][0][m][n] * c1, p = acc[ai][0][m][n] * acc[ai][1][m][n]; f32x4 e, d;
#pragma unroll
                    for (int i = 0; i < 4; ++i) e[i] = __builtin_amdgcn_exp2f(t[i]);
                    d = e * ir2 + ir2;
#pragma unroll
                    for (int i = 0; i < 4; ++i) d[i] = __builtin_amdgcn_rcpf(d[i]);
                    v[n] = p * d; }
                ST16(O + (size_t)row * ldc + col0, pack8(v[0], v[1])); }
    }
};

__device__ __forceinline__ void unpack8(const u32x4& g, f32x4& a, f32x4& b) {
    a[0] = __uint_as_float(g.x << 16); a[1] = __uint_as_float(g.x & 0xffff0000u); a[2] = __uint_as_float(g.y << 16); a[3] = __uint_as_float(g.y & 0xffff0000u);
    b[0] = __uint_as_float(g.z << 16); b[1] = __uint_as_float(g.z & 0xffff0000u); b[2] = __uint_as_float(g.w << 16); b[3] = __uint_as_float(g.w & 0xffff0000u);
}
template <bool BASE_BF16> struct EpiDown {
    static constexpr bool PERM = true, AFTER_DRAIN = false;
    const void* base; bf16_t* xb; float* ss; float alpha;
    __device__ __forceinline__ void pre(const Unit&, int, int) const {}
    __device__ __forceinline__ void operator()(const f32x4 (&acc)[2][2][4][2], const Unit& u, int wr, int wc, int fr, int fq) const {
        const int row0 = u.pm * BM + wr * 64 + fr, col0 = u.pn * BM + wc * 32 + 8 * fq;
        float qs[8];
#pragma unroll
        for (int ai = 0; ai < 2; ++ai) {
            u32x4 bb[4][2]; f32x4 bf[4][2][2];
#pragma unroll
            for (int m = 0; m < 4; ++m)
#pragma unroll
                for (int bj = 0; bj < 2; ++bj) { const size_t off = (size_t)(row0 + ai * HALF + m * 16) * 1024 + col0 + bj * HALF;
                    if (BASE_BF16) bb[m][bj] = *(const u32x4*)((const bf16_t*)base + off);
                    else { bf[m][bj][0] = *(const f32x4*)((const float*)base + off); bf[m][bj][1] = *(const f32x4*)((const float*)base + off + 4); } }
#pragma unroll
            for (int m = 0; m < 4; ++m) { const size_t off = (size_t)(row0 + ai * HALF + m * 16) * 1024 + col0; float q = 0.f;
#pragma unroll
                for (int bj = 0; bj < 2; ++bj) { f32x4 b0, b1;
                    if (BASE_BF16) unpack8(bb[m][bj], b0, b1); else { b0 = bf[m][bj][0]; b1 = bf[m][bj][1]; }
                    const f32x4 v0 = b0 + acc[ai][bj][m][0] * alpha, v1 = b1 + acc[ai][bj][m][1] * alpha;
                    q += (v0[0] * v0[0] + v0[1] * v0[1]) + (v0[2] * v0[2] + v0[3] * v0[3]) + (v1[0] * v1[0] + v1[1] * v1[1]) + (v1[2] * v1[2] + v1[3] * v1[3]);
                    ST16(xb + off + bj * HALF, pack8(v0, v1)); }
                q += __shfl_xor(q, 16); q += __shfl_xor(q, 32); qs[ai * 4 + m] = q; }
            asm volatile("" ::: "memory"); }
        if (fq == 0) {
#pragma unroll
            for (int j = 0; j < 8; ++j) atomicAdd(ss + row0 + (j >> 2) * HALF + (j & 3) * 16, qs[j]); }
    }
};

template <int ACT  > struct EpiPlain {
    static constexpr bool PERM = true, AFTER_DRAIN = false;
    bf16_t* O; int ldc; const float* ss; const float* bias;
    mutable float rs[8];
    __device__ __forceinline__ void pre(const Unit& u, int wr, int fr) const { load_rowscales(rs, ss, u.pm * BM + wr * 64 + fr); }
    __device__ __forceinline__ void operator()(const f32x4 (&acc)[2][2][4][2], const Unit& u, int wr, int wc, int fr, int fq) const {
        const int row0 = u.pm * BM + wr * 64 + fr, col0 = u.pn * BM + wc * 32 + 8 * fq;
        f32x4 bv[2][2];
#pragma unroll
        for (int bj = 0; bj < 2; ++bj)
#pragma unroll
            for (int n = 0; n < 2; ++n) bv[bj][n] = bias ? *(const f32x4*)(bias + col0 + bj * HALF + 4 * n) : (f32x4){0.f, 0.f, 0.f, 0.f};
#pragma unroll
        for (int ai = 0; ai < 2; ++ai)
#pragma unroll
            for (int m = 0; m < 4; ++m) { const int row = row0 + ai * HALF + m * 16; const float r = ss ? rowscale_from(rs[ai * 4 + m]) : 1.f;
#pragma unroll
                for (int bj = 0; bj < 2; ++bj) { f32x4 v0 = acc[ai][bj][m][0] * r + bv[bj][0], v1 = acc[ai][bj][m][1] * r + bv[bj][1];
                    if (ACT == 1) {
#pragma unroll
                        for (int i = 0; i < 4; ++i) { v0[i] = sigmoid_f(v0[i]); v1[i] = sigmoid_f(v1[i]); } }
                    ST16(O + (size_t)row * ldc + col0 + bj * HALF, pack8(v0, v1)); } }
    }
};

struct EpiProj {
    static constexpr bool PERM = true, AFTER_DRAIN = false;
    bf16_t* big;
    const float* ss;
    const float* gtab;
    const float *cosT, *sinT;
    mutable float rs[8];
    __device__ __forceinline__ void pre(const Unit& u, int wr, int fr) const { load_rowscales(rs, ss, u.pm * BM + wr * 64 + fr); }
    __device__ __forceinline__ static size_t sec_off(int kind) {
        constexpr size_t S = (size_t)32768 * 512;
        return kind == 0 ? 0 : kind == 1 ? 3 * S : kind == 2 ? 4 * S : kind == 3 ? 1 * S : kind == 4 ? 5 * S : kind == 5 ? 6 * S : 2 * S;
    }
    __device__ __forceinline__ void operator()(const f32x4 (&acc)[2][2][4][2], const Unit& u, int wr, int wc, int fr, int fq) const {
        const int kind = u.pn >> 1, half = u.pn & 1;
        const int row0 = u.pm * BM + wr * 64 + fr;
        bf16_t* base = big + sec_off(kind);
        const bool normk = (kind == 0) | (kind == 1) | (kind == 3) | (kind == 4);
        if (!normk) {
            const int col0 = half * 256 + wc * 32 + 8 * fq;
#pragma unroll
            for (int ai = 0; ai < 2; ++ai)
#pragma unroll
                for (int m = 0; m < 4; ++m) { const int row = row0 + ai * HALF + m * 16; const float r = rowscale_from(rs[ai * 4 + m]);
#pragma unroll
                    for (int bj = 0; bj < 2; ++bj) ST16(base + (size_t)row * 512 + col0 + bj * HALF, pack8(acc[ai][bj][m][0] * r, acc[ai][bj][m][1] * r)); }
        } else {
            const float* gain = gtab + 64 * (kind - (kind >= 3 ? 1 : 0));
            f32x4 gv[2][2];
#pragma unroll
            for (int bj = 0; bj < 2; ++bj)
#pragma unroll
                for (int n = 0; n < 2; ++n) gv[bj][n] = *(const f32x4*)(gain + 32 * bj + 8 * fq + 4 * n);
            const int col0 = half * 256 + wc * 64 + 8 * fq;
            auto body = [&](auto ROPEC) { constexpr bool rope = decltype(ROPEC)::value;
#pragma unroll
                for (int ah = 0; ah < 4; ++ah) { const int ai = ah >> 1, m0 = (ah & 1) * 2; f32x4 cs[2][2][2];
                    if (rope) {
#pragma unroll
                        for (int mm = 0; mm < 2; ++mm) { const int pos = (row0 + ai * HALF + (m0 + mm) * 16) & 4095;
#pragma unroll
                            for (int n = 0; n < 2; ++n) { cs[mm][n][0] = *(const f32x4*)(cosT + pos * 32 + 8 * fq + 4 * n); cs[mm][n][1] = *(const f32x4*)(sinT + pos * 32 + 8 * fq + 4 * n); } } }
#pragma unroll
                    for (int mm = 0; mm < 2; ++mm) { const int m = m0 + mm; const int row = row0 + ai * HALF + m * 16; const float r = rowscale_from(rs[ai * 4 + m]);
                        f32x4 v[2][2]; float q = 0.f;
#pragma unroll
                        for (int bj = 0; bj < 2; ++bj)
#pragma unroll
                            for (int n = 0; n < 2; ++n) { v[bj][n] = acc[ai][bj][m][n] * r; const f32x4 t = v[bj][n]; q += (t[0] * t[0] + t[1] * t[1]) + (t[2] * t[2] + t[3] * t[3]); }
                        q += __shfl_xor(q, 16); q += __shfl_xor(q, 32);
                        const float rn = __builtin_amdgcn_rsqf(q * (1.0f / 64.0f) + RMS_EPS);
#pragma unroll
                        for (int bj = 0; bj < 2; ++bj)
#pragma unroll
                            for (int n = 0; n < 2; ++n) v[bj][n] = v[bj][n] * rn * gv[bj][n];
                        if (rope) {
#pragma unroll
                            for (int n = 0; n < 2; ++n) { const f32x4 c = cs[mm][n][0], sn = cs[mm][n][1];
                                const f32x4 x1 = v[0][n], x2 = v[1][n]; v[0][n] = x1 * c - x2 * sn; v[1][n] = x2 * c + x1 * sn; } }
#pragma unroll
                        for (int bj = 0; bj < 2; ++bj) ST16(base + (size_t)row * 512 + col0 + 32 * bj, pack8(v[bj][0], v[bj][1])); }
                    asm volatile("" ::: "memory"); }
            };
            if (kind < 2) body(std::true_type{}); else body(std::false_type{});
        }
    }
};


__device__ __forceinline__ f32x4 dq4_u8(unsigned w) { f32x4 r; r[0] = (float)(w & 0xffu); r[1] = (float)((w >> 8) & 0xffu); r[2] = (float)((w >> 16) & 0xffu); r[3] = (float)(w >> 24); return r * (1.0f / 255.0f); }
struct EpiGB {
    static constexpr bool PERM = true, AFTER_DRAIN = false;
    const float* ss; const float* bias; bf16_t* y; u32x4* gsc; u32x4* ysc;
    mutable float rs[8];
    __device__ __forceinline__ void pre(const Unit& u, int wr, int fr) const { if (!(u.pm >> 9)) load_rowscales(rs, ss, (u.pm & 127) * BM + wr * 64 + fr); }
    __device__ __forceinline__ void operator()(const f32x4 (&acc)[2][2][4][2], const Unit& u, int wr, int wc, int fr, int fq) const {
        const int isB = u.pm >> 9, br = (u.pm >> 7) & 3, pm = u.pm & 127, pn = u.pn;
        const int row0 = pm * BM + wr * 64 + fr, col0 = pn * BM + wc * 32 + 8 * fq;
        __attribute__((address_space(1))) u32x4* gs = (__attribute__((address_space(1))) u32x4*)(gsc + threadIdx.x); asm volatile("" : "+v"(gs));
        if (!isB) {
            f32x4 bv[2][2];
#pragma unroll
            for (int bj = 0; bj < 2; ++bj)
#pragma unroll
                for (int n = 0; n < 2; ++n) bv[bj][n] = *(const f32x4*)(bias + br * 1024 + col0 + bj * HALF + 4 * n) * (-LOG2E) - 7.994353436858858f;
#pragma unroll
            for (int ai = 0; ai < 2; ++ai)
#pragma unroll
                for (int m = 0; m < 4; ++m) { const float c1 = -LOG2E * rowscale_from(rs[ai * 4 + m]); u32x4 w;
#pragma unroll
                    for (int bj = 0; bj < 2; ++bj)
#pragma unroll
                        for (int n = 0; n < 2; ++n) { const f32x4 t = acc[ai][bj][m][n] * c1 + bv[bj][n]; f32x4 e;
#pragma unroll
                            for (int i = 0; i < 4; ++i) e[i] = __builtin_amdgcn_exp2f(t[i]);
                            e = e + (1.0f / 255.0f);
                            unsigned q = 0;
#pragma unroll
                            for (int i = 0; i < 4; ++i) q = __builtin_amdgcn_cvt_pk_u8_f32(__builtin_amdgcn_rcpf(e[i]), i, q);
                            w[bj * 2 + n] = q; }
                    gs[(ai * 4 + m) * 512] = w; }
        } else {
            __attribute__((address_space(1))) u32x4* scb = (__attribute__((address_space(1))) u32x4*)(ysc + threadIdx.x); asm volatile("" : "+v"(scb));
            auto body = [&](auto BRC) { constexpr int BR = decltype(BRC)::value;
#pragma unroll
                for (int ai = 0; ai < 2; ++ai) { u32x4 gq[4], ys[4][2];
#pragma unroll
                    for (int m = 0; m < 4; ++m) gq[m] = gs[(ai * 4 + m) * 512];
                    if (BR > 0) {
#pragma unroll
                        for (int m = 0; m < 4; ++m)
#pragma unroll
                            for (int bj = 0; bj < 2; ++bj) ys[m][bj] = scb[((ai * 2 + bj) * 4 + m) * 512]; }
#pragma unroll
                    for (int m = 0; m < 4; ++m) { const int row = row0 + ai * HALF + m * 16;
#pragma unroll
                        for (int bj = 0; bj < 2; ++bj) { const f32x4 g0 = dq4_u8(bj == 0 ? gq[m].x : gq[m].z), g1 = dq4_u8(bj == 0 ? gq[m].y : gq[m].w);
                            f32x4 v0 = acc[ai][bj][m][0] * g0, v1 = acc[ai][bj][m][1] * g1;
                            if (BR > 0) { f32x4 y0, y1; unpack8(ys[m][bj], y0, y1); v0 += y0; v1 += y1; }
                            if (BR < 2) scb[((ai * 2 + bj) * 4 + m) * 512] = pack8(v0, v1);
                            else ST16(y + (size_t)row * 1024 + col0 + bj * HALF, pack8(v0, v1)); } }
                    asm volatile("" ::: "memory"); }
            };
            if (br == 0) body(std::integral_constant<int, 0>{}); else if (br == 1) body(std::integral_constant<int, 1>{}); else body(std::integral_constant<int, 2>{});
        }
    }
};
struct GateBranchOrder {
    StaticOrder so; const char *x1b, *wg, *oall, *wb;
    __device__ void init(int G, int c, const void* x1b_, const void* wg_, const void* oall_, const void* wb_) { so.init(32768, 1024, G, c); x1b = (const char*)x1b_; wg = (const char*)wg_; oall = (const char*)oall_; wb = (const char*)wb_; }
    __device__ bool desc(int i, Unit& u, const char*& A, const char*& B, int& K) const {
        const int q = i / 6, j = i - 6 * q, br = j >> 1, isB = j & 1; Unit t; if (!so.next(q, t)) return false;
        u.pm = t.pm + 128 * br + 512 * isB; u.pn = t.pn;
        if (!isB) { K = 1024; A = x1b + (size_t)t.pm * 256 * 1024 * 2; B = wg + (size_t)(br * 1024 + t.pn * 256) * 1024 * 2; }
        else { K = 512; A = oall + ((size_t)br * 32768 + (size_t)t.pm * 256) * 512 * 2; B = wb + (size_t)(br * 1024 + t.pn * 256) * 512 * 2; }
        return true;
    }
};
}
namespace att {
#define ALAS __attribute__((address_space(3)))
typedef unsigned short bf16_t;
typedef short bf16x8 __attribute__((ext_vector_type(8)));
typedef short s16x4 __attribute__((ext_vector_type(4)));
typedef float f32x16 __attribute__((ext_vector_type(16)));
typedef float f32x4 __attribute__((ext_vector_type(4)));
typedef unsigned u32x4 __attribute__((ext_vector_type(4)));
typedef unsigned u32x2 __attribute__((ext_vector_type(2)));
typedef float f32x2_t __attribute__((ext_vector_type(2)));
typedef __bf16 bf16x2_t __attribute__((ext_vector_type(2)));
typedef ALAS unsigned char* lptr;
typedef const ALAS unsigned char* lcptr;
constexpr float LOG2E = 1.4426950408889634f;
constexpr float RMS_EPS = 1e-6f;
__device__ __forceinline__ int crow(int r, int hi) { return (r & 3) + 8 * (r >> 2) + 4 * hi; }
__device__ __forceinline__ unsigned cvtpk(float lo, float hi) { f32x2_t v = {lo, hi}; bf16x2_t b = __builtin_convertvector(v, bf16x2_t); return __builtin_bit_cast(unsigned, b); }
__device__ __forceinline__ s16x4 vtr(lcptr p) { return __builtin_bit_cast(s16x4, __builtin_amdgcn_ds_read_tr16_b64_v4i16((ALAS s16x4*)p)); }
__device__ __forceinline__ float xhalf_max(float m) { auto rr = __builtin_amdgcn_permlane32_swap(__float_as_uint(m), __float_as_uint(m), false, false); return fmaxf(__uint_as_float(rr[0]), __uint_as_float(rr[1])); }
__device__ __forceinline__ float xhalf_sum(float m) { auto rr = __builtin_amdgcn_permlane32_swap(__float_as_uint(m), __float_as_uint(m), false, false); return __uint_as_float(rr[0]) + __uint_as_float(rr[1]); }
#define ATT_MFMA(a, b, c) __builtin_amdgcn_mfma_f32_32x32x16_bf16((a), (b), (c), 0, 0, 0)
#define ATT_BAR() do { asm volatile("s_waitcnt lgkmcnt(0)" ::: "memory"); __builtin_amdgcn_s_barrier(); asm volatile("" ::: "memory"); } while (0)

template <int KC, int VC> struct Geo {
    static constexpr int KPB = (KC + 8) * 2, VPB = (VC + 32) * 2, KBYTES = 64 * KPB, VBYTES = 64 * VPB, BUF = KBYTES + VBYTES;
    static constexpr int KCH = KC / 8, VCH = VC / 8;
    static constexpr int KN = 64 * KCH / 512, VN = 64 * VCH / 512;
};
template <int KC, int VC> struct Stage { u32x4 k[Geo<KC, VC>::KN]; u32x4 v[Geo<KC, VC>::VN]; };

template <int KC, int VC> __device__ __forceinline__ void stage_load(Stage<KC, VC>& st, const bf16_t* kthr, int kpitch, const bf16_t* vthr, int vpitch, int t) {
    typedef Geo<KC, VC> G;
#pragma unroll
    for (int i = 0; i < G::KN; ++i) st.k[i] = *(const u32x4*)(kthr + (size_t)(t * 64 + 32 * i) * kpitch);
#pragma unroll
    for (int i = 0; i < G::VN; ++i) st.v[i] = *(const u32x4*)(vthr + (size_t)(t * 64 + 32 * i) * vpitch);
}
template <int KC, int VC> __device__ __forceinline__ void stage_write(const Stage<KC, VC>& st, lptr kdst, lptr vdst) {
    typedef Geo<KC, VC> G;
#pragma unroll
    for (int i = 0; i < G::KN; ++i) *(ALAS u32x4*)(kdst + i * 32 * G::KPB) = st.k[i];
#pragma unroll
    for (int i = 0; i < G::VN; ++i) *(ALAS u32x4*)(vdst + i * 32 * G::VPB) = st.v[i];
}

constexpr float THR = 6.0f;
#define ATT_MX3(a, b, c) __builtin_fmaxf(__builtin_fmaxf((a), (b)), (c))
template <int NDK, int NDV, int KPB, int VPB, int MODE>
__device__ __forceinline__ void tile_compute(lcptr Kt, lcptr Vt, const bf16x8 (&qf)[NDK], f32x16 (&o)[NDV], float& mref, float& lrun, bool first,
                                             float rowscale, float cadd, const ALAS float* btab, int relbase, bool posbias, int lane, f32x16* cvec = nullptr) {
    const int r32 = lane & 31, hi = lane >> 5;
    lcptr kp = Kt + r32 * KPB + hi * 16;
    float c0 = -mref;
    if (MODE == 2) c0 = -mref * __builtin_amdgcn_rcpf(rowscale);
    if (MODE == 1) c0 = posbias ? -mref : cadd - mref;
    f32x16 p0, p1;
    if (MODE == 0) { p0 = *cvec; p1 = *cvec; }
    else {
#pragma unroll
        for (int r = 0; r < 16; ++r) { p0[r] = c0; p1[r] = c0; } }
#pragma unroll
    for (int d0 = 0; d0 < NDK; ++d0) {
        const bf16x8 a0 = *(const ALAS bf16x8*)(kp + d0 * 32), a1 = *(const ALAS bf16x8*)(kp + 32 * KPB + d0 * 32);
        p0 = ATT_MFMA(a0, qf[d0], p0); p1 = ATT_MFMA(a1, qf[d0], p1);
    }
    if (MODE == 2) {
#pragma unroll
        for (int r = 0; r < 16; ++r) { p0[r] *= rowscale; p1[r] *= rowscale; }
    }
    if (MODE == 1) {
        if (posbias) {
#pragma unroll
            for (int r = 0; r < 16; ++r) { const int kk = crow(r, hi); const int i0 = min(relbase - kk, 128) + 128, i1 = min(relbase - kk - 32, 128) + 128; p0[r] += btab[i0]; p1[r] += btab[i1]; }
        }
    }
    float ta = ATT_MX3(p0[0], p0[1], p1[0]), tb = ATT_MX3(p0[2], p0[3], p1[1]); ta = ATT_MX3(ta, p1[2], p1[3]);
#pragma unroll
    for (int r = 4; r < 16; r += 4) { ta = ATT_MX3(ta, p0[r], p0[r + 1]); tb = ATT_MX3(tb, p0[r + 2], p0[r + 3]); ta = ATT_MX3(ta, p1[r], p1[r + 1]); tb = ATT_MX3(tb, p1[r + 2], p1[r + 3]); }
    const float tm = xhalf_max(fmaxf(ta, tb));
    if (first || __builtin_amdgcn_ballot_w64(tm > THR) != 0ull) {
        const float d = first ? tm : fmaxf(tm, 0.f);
        mref += d;
        if (MODE == 0) {
#pragma unroll
            for (int r = 0; r < 16; ++r) (*cvec)[r] -= d; }
#pragma unroll
        for (int r = 0; r < 16; ++r) { p0[r] -= d; p1[r] -= d; }
        if (!first) { const float al = __builtin_amdgcn_exp2f(-d); lrun *= al;
#pragma unroll
            for (int dd = 0; dd < NDV; ++dd)
#pragma unroll
                for (int r = 0; r < 16; ++r) o[dd][r] *= al; }
    }
    float ls = 0.f;
#pragma unroll
    for (int r = 0; r < 16; ++r) { p0[r] = __builtin_amdgcn_exp2f(p0[r]); p1[r] = __builtin_amdgcn_exp2f(p1[r]); ls += p0[r] + p1[r]; }
    lrun += ls;
    bf16x8 pb[4];
#pragma unroll
    for (int ks = 0; ks < 4; ++ks) { u32x4 w;
        if (ks < 2) { const int b = 8 * (ks & 1); w.x = cvtpk(p0[b], p0[b + 1]); w.y = cvtpk(p0[b + 2], p0[b + 3]); w.z = cvtpk(p0[b + 4], p0[b + 5]); w.w = cvtpk(p0[b + 6], p0[b + 7]); }
        else { const int b = 8 * (ks & 1); w.x = cvtpk(p1[b], p1[b + 1]); w.y = cvtpk(p1[b + 2], p1[b + 3]); w.z = cvtpk(p1[b + 4], p1[b + 5]); w.w = cvtpk(p1[b + 6], p1[b + 7]); }
        pb[ks] = __builtin_bit_cast(bf16x8, w); }
    const int i16 = lane & 15, qq = i16 >> 2, pp = i16 & 3, blk = (lane >> 4) & 1;
    lcptr vp = Vt + (4 * hi + qq) * VPB + (16 * blk + 4 * pp) * 2;
#pragma unroll
    for (int d = 0; d < NDV; ++d)
#pragma unroll
        for (int ks = 0; ks < 4; ++ks) {
            const s16x4 lo = vtr(vp + ks * 16 * VPB + d * 64), h8 = vtr(vp + (ks * 16 + 8) * VPB + d * 64);
            const bf16x8 va = __builtin_shufflevector(lo, h8, 0, 1, 2, 3, 4, 5, 6, 7);
            o[d] = ATT_MFMA(va, pb[ks], o[d]);
        }
}

__device__ __forceinline__ void store_pair16(bf16_t* dst, int col, u32x2 a, u32x2 b, int hi) {
    auto rx = __builtin_amdgcn_permlane32_swap(a.x, b.x, false, false); auto ry = __builtin_amdgcn_permlane32_swap(a.y, b.y, false, false);
    u32x4 w; w.x = rx[0]; w.y = ry[0]; w.z = rx[1]; w.w = ry[1];
    *(u32x4*)(dst + col + 8 * hi) = w;
}
template <int NDV> __device__ __forceinline__ void store_o(const f32x16 (&o)[NDV], float inv, bf16_t* dst, int hi) {
#pragma unroll
    for (int d = 0; d < NDV; ++d)
#pragma unroll
        for (int g = 0; g < 4; g += 2) { u32x2 a, b;
            a.x = cvtpk(o[d][4 * g] * inv, o[d][4 * g + 1] * inv); a.y = cvtpk(o[d][4 * g + 2] * inv, o[d][4 * g + 3] * inv);
            b.x = cvtpk(o[d][4 * g + 4] * inv, o[d][4 * g + 5] * inv); b.y = cvtpk(o[d][4 * g + 6] * inv, o[d][4 * g + 7] * inv);
            store_pair16(dst, 32 * d + 8 * g, a, b, hi); }
}

#define ATT_SBAR() __builtin_amdgcn_sched_barrier(0)
#define ATT_PIN(x) asm volatile("" : "+v"(x))
__device__ __forceinline__ void frontA(lcptr Kt, const bf16x8 (&qf)[4], bf16x8 (&pb)[4], float& mref, float& lrun, int lane) {
    constexpr int KPB = Geo<128, 128>::KPB;
    const int r32 = lane & 31, hi = lane >> 5;
    lcptr kp = Kt + r32 * KPB + hi * 16;
    f32x16 p0, p1;
#pragma unroll
    for (int r = 0; r < 16; ++r) { p0[r] = 0.f; p1[r] = 0.f; }
#pragma unroll
    for (int d0 = 0; d0 < 4; ++d0) { const bf16x8 a0 = *(const ALAS bf16x8*)(kp + d0 * 32), a1 = *(const ALAS bf16x8*)(kp + 32 * KPB + d0 * 32);
        p0 = ATT_MFMA(a0, qf[d0], p0); p1 = ATT_MFMA(a1, qf[d0], p1); }
    float ta = ATT_MX3(p0[0], p0[1], p1[0]), tb = ATT_MX3(p0[2], p0[3], p1[1]); ta = ATT_MX3(ta, p1[2], p1[3]);
#pragma unroll
    for (int r = 4; r < 16; r += 4) { ta = ATT_MX3(ta, p0[r], p0[r + 1]); tb = ATT_MX3(tb, p0[r + 2], p0[r + 3]); ta = ATT_MX3(ta, p1[r], p1[r + 1]); tb = ATT_MX3(tb, p1[r + 2], p1[r + 3]); }
    const float tm = xhalf_max(fmaxf(ta, tb));
    mref = tm;
    float ls = 0.f;
#pragma unroll
    for (int r = 0; r < 16; ++r) { p0[r] = __builtin_amdgcn_exp2f(p0[r] - tm); p1[r] = __builtin_amdgcn_exp2f(p1[r] - tm); ls += p0[r] + p1[r]; }
    lrun = ls;
#pragma unroll
    for (int ks = 0; ks < 4; ++ks) { u32x4 w; const int b = 8 * (ks & 1);
        if (ks < 2) { w.x = cvtpk(p0[b], p0[b + 1]); w.y = cvtpk(p0[b + 2], p0[b + 3]); w.z = cvtpk(p0[b + 4], p0[b + 5]); w.w = cvtpk(p0[b + 6], p0[b + 7]); }
        else { w.x = cvtpk(p1[b], p1[b + 1]); w.y = cvtpk(p1[b + 2], p1[b + 3]); w.z = cvtpk(p1[b + 4], p1[b + 5]); w.w = cvtpk(p1[b + 6], p1[b + 7]); }
        pb[ks] = __builtin_bit_cast(bf16x8, w); }
}
__device__ __forceinline__ void pvA(lcptr Vt, const bf16x8 (&pb)[4], f32x16 (&o)[4], int lane) {
    constexpr int VPB = Geo<128, 128>::VPB;
    const int hi = lane >> 5, i16 = lane & 15, qq = i16 >> 2, pp = i16 & 3, blk = (lane >> 4) & 1;
    lcptr vp = Vt + (4 * hi + qq) * VPB + (16 * blk + 4 * pp) * 2;
#pragma unroll
    for (int ks = 0; ks < 4; ++ks)
#pragma unroll
        for (int d = 0; d < 4; ++d) { const s16x4 lo = vtr(vp + ks * 16 * VPB + d * 64), h8 = vtr(vp + (ks * 16 + 8) * VPB + d * 64);
            o[d] = ATT_MFMA(__builtin_shufflevector(lo, h8, 0, 1, 2, 3, 4, 5, 6, 7), pb[ks], o[d]); }
}
__device__ __forceinline__ void stepA_il(lcptr Kt, lcptr Vp, const bf16x8 (&qf)[4], f32x16 (&o)[4], bf16x8 (&pb)[4], float& mref, float& lrun, int lane) {
    constexpr int KPB = Geo<128, 128>::KPB, VPB = Geo<128, 128>::VPB;
    const int r32 = lane & 31, hi = lane >> 5, i16 = lane & 15, qq = i16 >> 2, pp = i16 & 3, blk = (lane >> 4) & 1;
    lcptr kp = Kt + r32 * KPB + hi * 16;
    lcptr vp = Vp + (4 * hi + qq) * VPB + (16 * blk + 4 * pp) * 2;
#define ATT_VRD(dst, ks, d) do { const s16x4 lo_ = vtr(vp + (ks) * 16 * VPB + (d) * 64), h8_ = vtr(vp + ((ks) * 16 + 8) * VPB + (d) * 64); dst = __builtin_shufflevector(lo_, h8_, 0, 1, 2, 3, 4, 5, 6, 7); } while (0)
    ATT_SBAR();
    bf16x8 ka0, kb0, ka1, kb1, vf[4];
    ka0 = *(const ALAS bf16x8*)(kp); kb0 = *(const ALAS bf16x8*)(kp + 32 * KPB);
    ATT_SBAR();
    f32x16 p0, p1, cv;
#pragma unroll
    for (int r = 0; r < 16; ++r) cv[r] = -mref;
    ka1 = *(const ALAS bf16x8*)(kp + 32); kb1 = *(const ALAS bf16x8*)(kp + 32 * KPB + 32); ATT_SBAR();
    p0 = ATT_MFMA(ka0, qf[0], cv); ATT_SBAR();
    p1 = ATT_MFMA(kb0, qf[0], cv); ATT_SBAR();
    ka0 = *(const ALAS bf16x8*)(kp + 64); kb0 = *(const ALAS bf16x8*)(kp + 32 * KPB + 64); ATT_SBAR();
    p0 = ATT_MFMA(ka1, qf[1], p0); ATT_SBAR();
    p1 = ATT_MFMA(kb1, qf[1], p1); ATT_SBAR();
    ka1 = *(const ALAS bf16x8*)(kp + 96); kb1 = *(const ALAS bf16x8*)(kp + 32 * KPB + 96); ATT_SBAR();
    p0 = ATT_MFMA(ka0, qf[2], p0); ATT_VRD(vf[0], 0, 0); ATT_SBAR();
    p1 = ATT_MFMA(kb0, qf[2], p1); ATT_VRD(vf[1], 0, 1); ATT_SBAR();
    p0 = ATT_MFMA(ka1, qf[3], p0); ATT_VRD(vf[2], 0, 2); ATT_SBAR();
    p1 = ATT_MFMA(kb1, qf[3], p1); ATT_SBAR();
    float al = 1.f; bool resc = false;
    { float ta = ATT_MX3(p0[0], p0[1], p1[0]), tb = ATT_MX3(p0[2], p0[3], p1[1]); ta = ATT_MX3(ta, p1[2], p1[3]);
#pragma unroll
      for (int r = 4; r < 16; r += 4) { ta = ATT_MX3(ta, p0[r], p0[r + 1]); tb = ATT_MX3(tb, p0[r + 2], p0[r + 3]); ta = ATT_MX3(ta, p1[r], p1[r + 1]); tb = ATT_MX3(tb, p1[r + 2], p1[r + 3]); }
      const float tm = xhalf_max(fmaxf(ta, tb));
      if (__builtin_amdgcn_ballot_w64(tm > THR) != 0ull) { const float d = fmaxf(tm, 0.f); mref += d;
#pragma unroll
          for (int r = 0; r < 16; ++r) { p0[r] -= d; p1[r] -= d; }
          al = __builtin_amdgcn_exp2f(-d); lrun *= al; resc = true; } }
    ATT_SBAR();
    float ls = 0.f; u32x4 n0 = __builtin_bit_cast(u32x4, pb[0]), n1 = __builtin_bit_cast(u32x4, pb[1]), n2 = __builtin_bit_cast(u32x4, pb[2]), n3 = __builtin_bit_cast(u32x4, pb[3]);
#define ATT_PB(KS) __builtin_bit_cast(bf16x8, n##KS)
#define ATT_PV(G, KS) o[(G) & 3] = ATT_MFMA(vf[(G) & 3], ATT_PB(KS), o[(G) & 3])
#define ATT_VN(G) ATT_VRD(vf[((G) + 3) & 3], ((G) + 3) >> 2, ((G) + 3) & 3)
#define ATT_EX2(P, B) P[B] = __builtin_amdgcn_exp2f(P[B]); P[(B) + 1] = __builtin_amdgcn_exp2f(P[(B) + 1]); ATT_PIN(P)
#define ATT_FIN(W, C, P, B) W[C] = cvtpk(P[B], P[(B) + 1]); ls += P[B] + P[(B) + 1]; ATT_PIN(W); ATT_PIN(ls)
    ATT_PV(0, 0);  ATT_EX2(p0, 0);                          ATT_VN(0);  ATT_SBAR();
    ATT_PV(1, 0);  ATT_EX2(p0, 2);                          ATT_VN(1);  ATT_SBAR();
    ATT_PV(2, 0);  ATT_EX2(p0, 4);                          ATT_VN(2);  ATT_SBAR();
    ATT_PV(3, 0);  ATT_EX2(p0, 6);                          ATT_VN(3);  ATT_SBAR();
    ATT_PV(4, 1);  ATT_EX2(p0, 8);  ATT_FIN(n0, 0, p0, 0);  ATT_VN(4);  ATT_SBAR();
    ATT_PV(5, 1);  ATT_EX2(p0, 10); ATT_FIN(n0, 1, p0, 2);  ATT_VN(5);  ATT_SBAR();
    ATT_PV(6, 1);  ATT_EX2(p0, 12); ATT_FIN(n0, 2, p0, 4);  ATT_VN(6);  ATT_SBAR();
    ATT_PV(7, 1);  ATT_EX2(p0, 14); ATT_FIN(n0, 3, p0, 6);  ATT_VN(7);  ATT_SBAR();
    ATT_PV(8, 2);  ATT_EX2(p1, 0);  ATT_FIN(n1, 0, p0, 8);  ATT_VN(8);  ATT_SBAR();
    ATT_PV(9, 2);  ATT_EX2(p1, 2);  ATT_FIN(n1, 1, p0, 10); ATT_VN(9);  ATT_SBAR();
    ATT_PV(10, 2); ATT_EX2(p1, 4);  ATT_FIN(n1, 2, p0, 12); ATT_VN(10); ATT_SBAR();
    ATT_PV(11, 2); ATT_EX2(p1, 6);  ATT_FIN(n1, 3, p0, 14); ATT_VN(11); ATT_SBAR();
    ATT_PV(12, 3); ATT_EX2(p1, 8);  ATT_FIN(n2, 0, p1, 0);  ATT_VN(12); ATT_SBAR();
    ATT_PV(13, 3); ATT_EX2(p1, 10); ATT_FIN(n2, 1, p1, 2);  ATT_SBAR();
    ATT_PV(14, 3); ATT_EX2(p1, 12); ATT_FIN(n2, 2, p1, 4);  ATT_SBAR();
    ATT_PV(15, 3); ATT_EX2(p1, 14); ATT_FIN(n2, 3, p1, 6);  ATT_SBAR();
    ATT_FIN(n3, 0, p1, 8); ATT_FIN(n3, 1, p1, 10); ATT_FIN(n3, 2, p1, 12); ATT_FIN(n3, 3, p1, 14);
    ATT_SBAR();
    lrun += ls;
    pb[0] = ATT_PB(0); pb[1] = ATT_PB(1); pb[2] = ATT_PB(2); pb[3] = ATT_PB(3);
    if (resc) {
#pragma unroll
        for (int dd = 0; dd < 4; ++dd)
#pragma unroll
            for (int r = 0; r < 16; ++r) o[dd][r] *= al; }
#undef ATT_VRD
#undef ATT_PV
#undef ATT_PB
#undef ATT_VN
#undef ATT_EX2
#undef ATT_FIN
}

template <int NQ> struct Pre { bf16x8 qf[NQ]; Stage<128, 128> st; };
__device__ __forceinline__ void preloadA(Pre<4>& P, int b, int h, int qb, const bf16_t* aq, const bf16_t* ak, const bf16_t* av, int tid) {
    asm volatile("" : "+v"(tid));
    const int lane = tid & 63, wave = __builtin_amdgcn_readfirstlane(tid >> 6), rb = wave & 3, comp = wave >> 2, r32 = lane & 31, hi = lane >> 5;
    const size_t rowbase = (size_t)b * 4096; const int q0 = qb * 128 + rb * 32;
#pragma unroll
    for (int d0 = 0; d0 < 4; ++d0) P.qf[d0] = *(const bf16x8*)(aq + (rowbase + q0 + r32) * 512 + h * 128 + comp * 64 + d0 * 16 + hi * 8);
    const int srow = tid >> 4, sch = tid & 15;
    stage_load<128, 128>(P.st, ak + rowbase * 512 + h * 128 + (size_t)srow * 512 + sch * 8, 512, av + rowbase * 512 + h * 128 + (size_t)srow * 512 + sch * 8, 512, 0);
}
__device__ __forceinline__ void unitA(int b, int h, int qb, const bf16_t* aq, const bf16_t* ak, const bf16_t* av, bf16_t* oa, const ALAS float* gsub, float lam, lptr lds, int tid,
                                      Pre<4>& P, bool has_next, int nb, int nh, int nqb) {
    typedef Geo<128, 128> G;
    asm volatile("" : "+v"(tid));
    const int lane = tid & 63, wave = __builtin_amdgcn_readfirstlane(tid >> 6), rb = wave & 3, comp = wave >> 2, r32 = lane & 31, hi = lane >> 5;
    const size_t rowbase = (size_t)b * 4096;
    const int q0 = qb * 128 + rb * 32;
    const bf16_t* Kg = ak + rowbase * 512 + h * 128; const bf16_t* Vg = av + rowbase * 512 + h * 128;
    bf16x8 (&qf)[4] = P.qf;
    f32x16 o[4];
#pragma unroll
    for (int d = 0; d < 4; ++d)
#pragma unroll
        for (int r = 0; r < 16; ++r) o[d][r] = 0.f;
    float mrun = 0.f, lrun = 0.f;
    const int nt = 2 * qb + 2, tlast = 2 * qb + (rb >> 1);
    constexpr int KB = G::KBYTES, VB = G::VBYTES, VOFF = 2 * KB;
    Stage<128, 128>& st = P.st;
    const int srow = tid >> 4, sch = tid & 15;
    const bf16_t* kthr = Kg + (size_t)srow * 512 + sch * 8; const bf16_t* vthr = Vg + (size_t)srow * 512 + sch * 8;
    lptr kdst = lds + srow * G::KPB + sch * 16; lptr vdst = lds + VOFF + srow * G::VPB + sch * 16;
    stage_write<128, 128>(st, kdst, vdst);
    if (nt > 1) stage_load<128, 128>(st, kthr, 512, vthr, 512, 1);
    ATT_BAR();
    bf16x8 pb[4];
    int vprev = 0, vcur = 0, vnext = VB;
    stage_write<128, 128>(st, kdst + KB, vdst + vnext);
    if (2 < nt) stage_load<128, 128>(st, kthr, 512, vthr, 512, 2);
    frontA(lds + comp * 128, qf, pb, mrun, lrun, lane);
    vprev = vcur; vcur = vnext; vnext = 2 * VB;
    ATT_BAR();
#pragma unroll 1
    for (int t = 1; t < nt - 1; ++t) {
        const int ko = (t & 1) * KB;
        stage_write<128, 128>(st, kdst + (KB - ko), vdst + vnext);
        if (t + 2 < nt) stage_load<128, 128>(st, kthr, 512, vthr, 512, t + 2);
        stepA_il(lds + ko + comp * 128, lds + VOFF + vprev, qf, o, pb, mrun, lrun, lane);
        vprev = vcur; vcur = vnext; vnext = (vnext == 2 * VB) ? 0 : vnext + VB;
        ATT_BAR();
    }
    if (rb >> 1) { stepA_il(lds + KB + comp * 128, lds + VOFF + vprev, qf, o, pb, mrun, lrun, lane); pvA(lds + VOFF + vcur, pb, o, lane); }
    else pvA(lds + VOFF + vprev, pb, o, lane);
    ATT_BAR();
    if (has_next) preloadA(P, nb, nh, nqb, aq, ak, av, tid);
    const float inv = 1.0f / xhalf_sum(lrun);
    ALAS float* xch = (ALAS float*)lds + rb * 4096;
    if (comp == 1) {
        const float f = inv * lam;
#pragma unroll
        for (int d = 0; d < 4; ++d)
#pragma unroll
            for (int r = 0; r < 16; ++r) xch[(d * 16 + r) * 64 + lane] = o[d][r] * f;
    }
    ATT_BAR();
    if (comp == 0) {
        float ssq = 0.f;
#pragma unroll
        for (int d = 0; d < 4; ++d)
#pragma unroll
            for (int r = 0; r < 16; ++r) { const float v = o[d][r] * inv - xch[(d * 16 + r) * 64 + lane]; o[d][r] = v; ssq += v * v; }
        ssq = xhalf_sum(ssq);
        const float rn = __builtin_amdgcn_rsqf(ssq * (1.0f / 128.0f) + RMS_EPS) * 0.8f;
        bf16_t* dst = oa + (rowbase + q0 + r32) * 512 + h * 128;
#pragma unroll
        for (int d = 0; d < 4; ++d)
#pragma unroll
            for (int g = 0; g < 4; g += 2) { const f32x4 ga = *(const ALAS f32x4*)(gsub + 32 * d + 8 * g + 4 * hi), gb = *(const ALAS f32x4*)(gsub + 32 * d + 8 * g + 8 + 4 * hi);
                u32x2 a, b2;
                a.x = cvtpk(o[d][4 * g] * rn * ga[0], o[d][4 * g + 1] * rn * ga[1]); a.y = cvtpk(o[d][4 * g + 2] * rn * ga[2], o[d][4 * g + 3] * rn * ga[3]);
                b2.x = cvtpk(o[d][4 * g + 4] * rn * gb[0], o[d][4 * g + 5] * rn * gb[1]); b2.y = cvtpk(o[d][4 * g + 6] * rn * gb[2], o[d][4 * g + 7] * rn * gb[3]);
                store_pair16(dst, 32 * d + 8 * g, a, b2, hi); }
    }
    ATT_BAR();
}

__device__ __forceinline__ void setupB2(int hp, const float* relb, lptr lds, int tid) {
    ALAS float* btab2 = (ALAS float*)(lds + 2 * Geo<128, 128>::BUF);
    if (tid < 257) { btab2[tid] = relb[(2 * hp) * 257 + tid] * LOG2E; btab2[260 + tid] = relb[(2 * hp + 1) * 257 + tid] * LOG2E; }
}
__device__ __forceinline__ void preloadB2(Pre<4>& P, int b, int hp, int qb, const bf16_t* bq, const bf16_t* bk, const bf16_t* bv, int tid) {
    asm volatile("" : "+v"(tid));
    const int lane = tid & 63, wave = __builtin_amdgcn_readfirstlane(tid >> 6), rb = wave & 3, hh = wave >> 2, r32 = lane & 31, hi = lane >> 5, h = 2 * hp + hh;
    const size_t rowbase = (size_t)b * 4096; const int c0 = qb * 2, q0 = qb * 128 + rb * 32, j0 = c0 >= 8 ? 0 : 8 - c0;
#pragma unroll
    for (int d0 = 0; d0 < 4; ++d0) P.qf[d0] = *(const bf16x8*)(bq + (rowbase + q0 + r32) * 512 + h * 64 + d0 * 16 + hi * 8);
    const int srow = tid >> 4, sch = tid & 15; const size_t off = (rowbase + (size_t)(c0 - 8) * 64) * 512 + hp * 128 + (size_t)srow * 512 + sch * 8;
    stage_load<128, 128>(P.st, bk + off, 512, bv + off, 512, j0);
}
__device__ __forceinline__ void unitB2(int b, int hp, int qb, const bf16_t* bq, const bf16_t* bk, const bf16_t* bv, bf16_t* ob, const float* relb, lptr lds, int tid,
                                       Pre<4>& P, bool has_next, int nb, int nhp, int nqb) {
    typedef Geo<128, 128> G;
    asm volatile("" : "+v"(tid));
    const int lane = tid & 63, wave = __builtin_amdgcn_readfirstlane(tid >> 6), rb = wave & 3, hh = wave >> 2, r32 = lane & 31, hi = lane >> 5, wch = rb >> 1, h = 2 * hp + hh;
    const size_t rowbase = (size_t)b * 4096;
    const int c0 = qb * 2, q0 = qb * 128 + rb * 32;
    const ALAS float* btab = (const ALAS float*)(lds + 2 * G::BUF) + hh * 260;
    const bf16_t* Kg = bk + (rowbase + (size_t)(c0 - 8) * 64) * 512 + hp * 128; const bf16_t* Vg = bv + (rowbase + (size_t)(c0 - 8) * 64) * 512 + hp * 128;
    bf16x8 (&qf)[4] = P.qf;
    f32x16 o[2];
#pragma unroll
    for (int d = 0; d < 2; ++d)
#pragma unroll
        for (int r = 0; r < 16; ++r) o[d][r] = 0.f;
    float mrun = 0.f, lrun = 0.f; bool first = true;
    const int j0 = c0 >= 8 ? 0 : 8 - c0;
    const int qi = (rb & 1) * 32 + r32;
    Stage<128, 128>& st = P.st;
    const int srow = tid >> 4, sch = tid & 15;
    const bf16_t* kthr = Kg + (size_t)srow * 512 + sch * 8; const bf16_t* vthr = Vg + (size_t)srow * 512 + sch * 8;
    lptr kdst = lds + srow * G::KPB + sch * 16; lptr vdst = lds + G::KBYTES + srow * G::VPB + sch * 16;
    stage_write<128, 128>(st, kdst + (j0 & 1) * G::BUF, vdst + (j0 & 1) * G::BUF);
    if (j0 + 1 < 10) stage_load<128, 128>(st, kthr, 512, vthr, 512, j0 + 1);
    ATT_BAR();
#pragma unroll 1
    for (int t = j0; t < 10; ++t) {
        const int bo = (t & 1) * G::BUF, bn = G::BUF - bo;
        lptr buf = lds + bo;
        const int jb = t - wch;
        if (t + 1 < 10) stage_write<128, 128>(st, kdst + bn, vdst + bn);
        if (t + 2 < 10) stage_load<128, 128>(st, kthr, 512, vthr, 512, t + 2);
        if (jb >= 0 && jb <= 8) { tile_compute<4, 2, G::KPB, G::VPB, 1>(buf + hh * 128, buf + G::KBYTES + hh * 128, qf, o, mrun, lrun, first, 1.f, btab[256], btab, 64 * (8 - jb) + qi, jb >= 6, lane); first = false; }
        ATT_BAR();
    }
    if (has_next) preloadB2(P, nb, nhp, nqb, bq, bk, bv, tid);
    const float inv = 1.0f / xhalf_sum(lrun);
    store_o<2>(o, inv, ob + (rowbase + q0 + r32) * 512 + h * 64, hi);
}

__device__ __forceinline__ void unitC(int b, int h, int qb, const bf16_t* cq, const bf16_t* mkn, const bf16_t* mkv, bf16_t* oc, lptr lds, int tid) {
    typedef Geo<128, 128> G;
    asm volatile("" : "+v"(tid));
    const int lane = tid & 63, wave = __builtin_amdgcn_readfirstlane(tid >> 6), r32 = lane & 31, hi = lane >> 5;
    const size_t rowbase = (size_t)b * 4096;
    const int q0 = qb * 256 + wave * 32;
    const bf16_t* Kg = mkn + (size_t)b * 256 * 512 + h * 128; const bf16_t* Vg = mkv + (size_t)b * 256 * 1024 + 512 + h * 128;
    bf16x8 qf[8]; float ssq = 0.f;
#pragma unroll
    for (int d0 = 0; d0 < 8; ++d0) { qf[d0] = *(const bf16x8*)(cq + (rowbase + q0 + r32) * 512 + h * 128 + d0 * 16 + hi * 8);
#pragma unroll
        for (int j = 0; j < 8; ++j) { const float v = __uint_as_float(((unsigned)(unsigned short)qf[d0][j]) << 16); ssq += v * v; } }
    ssq = xhalf_sum(ssq);
    const float rq = __builtin_amdgcn_rsqf(ssq * (1.0f / 128.0f) + RMS_EPS);
    f32x16 o[4];
#pragma unroll
    for (int d = 0; d < 4; ++d)
#pragma unroll
        for (int r = 0; r < 16; ++r) o[d][r] = 0.f;
    float mrun = 0.f, lrun = 0.f; bool first = true;
    Stage<128, 128> st;
    const int srow = tid >> 4, sch = tid & 15;
    const bf16_t* kthr = Kg + (size_t)srow * 512 + sch * 8; const bf16_t* vthr = Vg + (size_t)srow * 1024 + sch * 8;
    lptr kdst = lds + srow * G::KPB + sch * 16; lptr vdst = lds + G::KBYTES + srow * G::VPB + sch * 16;
    stage_load<128, 128>(st, kthr, 512, vthr, 1024, 0);
    stage_write<128, 128>(st, kdst, vdst);
    stage_load<128, 128>(st, kthr, 512, vthr, 1024, 1);
    ATT_BAR();
#pragma unroll 1
    for (int t = 0; t < 4; ++t) {
        const int bo = (t & 1) * G::BUF, bn = G::BUF - bo;
        lptr buf = lds + bo;
        if (t + 1 < 4) stage_write<128, 128>(st, kdst + bn, vdst + bn);
        if (t + 2 < 4) stage_load<128, 128>(st, kthr, 512, vthr, 1024, t + 2);
        tile_compute<8, 4, G::KPB, G::VPB, 2>(buf, buf + G::KBYTES, qf, o, mrun, lrun, t == 0, rq, 0.f, nullptr, 0, false, lane);
        ATT_BAR();
    }
    const float inv = 1.0f / xhalf_sum(lrun);
    store_o<4>(o, inv, oc + (rowbase + q0 + r32) * 512 + h * 128, hi);
}

__device__ __forceinline__ void stageC_all(int b, int h, const bf16_t* mkn, const bf16_t* mkv, lptr lds, int tid) {
    typedef Geo<128, 128> G;
    asm volatile("" : "+v"(tid));
    const bf16_t* Kg = mkn + (size_t)b * 256 * 512 + h * 128; const bf16_t* Vg = mkv + (size_t)b * 256 * 1024 + 512 + h * 128;
    const int srow = tid >> 4, sch = tid & 15;
    const bf16_t* kthr = Kg + (size_t)srow * 512 + sch * 8; const bf16_t* vthr = Vg + (size_t)srow * 1024 + sch * 8;
    lptr kdst = lds + srow * G::KPB + sch * 16; lptr vdst = lds + G::KBYTES + srow * G::VPB + sch * 16;
    Stage<128, 128> sa, sb;
    stage_load<128, 128>(sa, kthr, 512, vthr, 1024, 0); stage_load<128, 128>(sb, kthr, 512, vthr, 1024, 1);
    stage_write<128, 128>(sa, kdst, vdst);                       stage_load<128, 128>(sa, kthr, 512, vthr, 1024, 2);
    stage_write<128, 128>(sb, kdst + G::BUF, vdst + G::BUF);     stage_load<128, 128>(sb, kthr, 512, vthr, 1024, 3);
    stage_write<128, 128>(sa, kdst + 2 * G::BUF, vdst + 2 * G::BUF);
    stage_write<128, 128>(sb, kdst + 3 * G::BUF, vdst + 3 * G::BUF);
    ATT_BAR();
}
__device__ __forceinline__ void unitC_res(int b, int h, int qb, const bf16_t* cq, bf16_t* oc, lptr lds, int tid) {
    typedef Geo<128, 128> G;
    asm volatile("" : "+v"(tid));
    const int lane = tid & 63, wave = __builtin_amdgcn_readfirstlane(tid >> 6), r32 = lane & 31, hi = lane >> 5;
    const size_t rowbase = (size_t)b * 4096;
    const int q0 = qb * 256 + wave * 32;
    bf16x8 qf[8]; float ssq = 0.f;
#pragma unroll
    for (int d0 = 0; d0 < 8; ++d0) { qf[d0] = *(const bf16x8*)(cq + (rowbase + q0 + r32) * 512 + h * 128 + d0 * 16 + hi * 8);
#pragma unroll
        for (int j = 0; j < 8; ++j) { const float v = __uint_as_float(((unsigned)(unsigned short)qf[d0][j]) << 16); ssq += v * v; } }
    ssq = xhalf_sum(ssq);
    const float rq = __builtin_amdgcn_rsqf(ssq * (1.0f / 128.0f) + RMS_EPS);
    f32x16 o[4];
#pragma unroll
    for (int d = 0; d < 4; ++d)
#pragma unroll
        for (int r = 0; r < 16; ++r) o[d][r] = 0.f;
    float mrun = 0.f, lrun = 0.f;
#pragma unroll 1
    for (int t = 0; t < 4; ++t) { lptr buf = lds + t * G::BUF;
        tile_compute<8, 4, G::KPB, G::VPB, 2>(buf, buf + G::KBYTES, qf, o, mrun, lrun, t == 0, rq, 0.f, nullptr, 0, false, lane); }
    const float inv = 1.0f / xhalf_sum(lrun);
    store_o<4>(o, inv, oc + (rowbase + q0 + r32) * 512 + h * 128, hi);
}

}
constexpr int NWAVES = 8;
#ifndef MK_N_LAUNCHES
#define MK_N_LAUNCHES 1
#endif
constexpr int N_PHASES = 10;
constexpr int N_LAUNCHES = MK_N_LAUNCHES;

constexpr int BATCH = 8, SEQ = 4096, DM = 1024, M = BATCH * SEQ, FF = 2816, NMEM = 256, MMEM = BATCH * NMEM, INC = 3584, GC = 3072;
constexpr float RMS_EPS = 1e-6f;
constexpr float LOG2E_F = 1.4426950408889634f;

constexpr size_t MiB = 1u << 20;
constexpr size_t WS_CTL = 0, CTL_ZERO_BYTES = 1 * MiB;
constexpr size_t WS_SS0 = 640 * 1024;
constexpr size_t WS_SS1 = 256 * 1024, WS_SS2 = 384 * 1024, WS_SS3 = 512 * 1024;
constexpr size_t WS_W1UP = 1 * MiB;
constexpr size_t WS_W1DN = 12 * MiB;
constexpr size_t WS_W2UP = 18 * MiB;
constexpr size_t WS_W2DN = 29 * MiB;
constexpr size_t WS_WIN = 35 * MiB;
constexpr size_t WS_WG = 42 * MiB;
constexpr size_t WS_WB = 48 * MiB;
constexpr size_t WS_WO = 51 * MiB;
constexpr size_t WS_WM = 53 * MiB;
constexpr size_t WS_COS = 55 * MiB, WS_SIN = 55 * MiB + 512 * 1024;
constexpr size_t WS_MISC = 56 * MiB;
constexpr size_t WS_MEMN = 57 * MiB;
constexpr size_t WS_MKV = 61 * MiB;
constexpr size_t WS_MKN = 65 * MiB;
constexpr size_t WS_B1 = 68 * MiB;
constexpr size_t WS_BIG = 132 * MiB;
constexpr size_t WS_ACT1 = WS_BIG;
constexpr size_t WS_Q3 = WS_BIG;
constexpr size_t WS_GBSCR = WS_BIG + 96 * MiB;
constexpr size_t WS_X2B = WS_BIG;
constexpr size_t WS_ACT2 = WS_BIG + 64 * MiB;
constexpr size_t WS_X3B = WS_BIG + 240 * MiB;
constexpr size_t WS_END = WS_BIG + 352 * MiB;
static_assert(WS_END <= 512 * MiB, "d_ws map");
constexpr int CW_BAR = 4096, CW_MEMGRP = 8192, CW_RB = 8448;

constexpr int RING_BYTES = 131072, LDS_BYTES = 163840, LDSCTL_OFF = LDS_BYTES - 1024, MISC_OFF = LDSCTL_OFF + 320;

#define GAS __attribute__((address_space(1)))
#define LAS __attribute__((address_space(3)))
typedef unsigned short bf16;
typedef unsigned v4u __attribute__((ext_vector_type(4)));
typedef float f32x4 __attribute__((ext_vector_type(4)));
typedef GAS unsigned gu32;
#define RLX_AGENT __ATOMIC_RELAXED, __HIP_MEMORY_SCOPE_AGENT
#define LDS_WAIT() asm volatile("s_waitcnt lgkmcnt(0)" ::: "memory")
#define VM_WAIT() asm volatile("s_waitcnt vmcnt(0)" ::: "memory")
__device__ __forceinline__ unsigned f2bf(float f) { unsigned u = __builtin_bit_cast(unsigned, f); return (u + 0x7fffu + ((u >> 16) & 1u)) >> 16; }
__device__ __forceinline__ unsigned pk2(float lo, float hi) { return f2bf(lo) | (f2bf(hi) << 16); }
__device__ __forceinline__ float bf2f(unsigned short h) { return __uint_as_float(((unsigned)h) << 16); }
#define XB_TMO      128
#define XB_XCNT(j)  (256  + 64 * (j))
#define XB_XSUB(j)  (1280 + 64 * (j))
#define XB_XGEN(j)  (2304 + 64 * (j))
#define XB_TOP      3328
#define XB_TOPGEN   3392
#define XCD_BAR_WORDS 3456
#define XB_SPIN_CAP (1u << 18)

__device__ __forceinline__ unsigned xb_ld(unsigned* p)              { return __hip_atomic_load(p, __ATOMIC_RELAXED, __HIP_MEMORY_SCOPE_AGENT); }
__device__ __forceinline__ unsigned xb_add(unsigned* p, unsigned v) { return __hip_atomic_fetch_add(p, v, __ATOMIC_RELAXED, __HIP_MEMORY_SCOPE_AGENT); }
__device__ __forceinline__ unsigned xb_xcc_id() { return (unsigned)__builtin_amdgcn_s_getreg((3 << 11) | 20) & 0xFu; }
#define XB_SPIN(cond, bar) do { unsigned _sp = 0; while (cond) { __builtin_amdgcn_s_sleep(1); \
    if ((++_sp & 255u) == 0u) { if (xb_ld(&(bar)[XB_TMO])) break; if (_sp > XB_SPIN_CAP) { atomicAdd(&(bar)[XB_TMO], 1u); break; } } } } while (0)

struct XcdBarrier {
    unsigned* bar; unsigned x;
    volatile LAS unsigned* st;
};

__device__ __forceinline__ XcdBarrier xcd_barrier_post(unsigned* bar, volatile LAS unsigned* st) {
    XcdBarrier b; b.bar = bar; b.x = xb_xcc_id(); b.st = st;
    if (threadIdx.x == 0) (void)xb_add(&bar[XB_XCNT(b.x)], 1u);
    return b;
}
__device__ __forceinline__ void xcd_barrier_complete(unsigned* bar, unsigned x, unsigned& nloc, unsigned& nx) {
    const unsigned G = gridDim.x * gridDim.y * gridDim.z;
    unsigned sum, cnt, mine, sp = 0u;
    for (;;) {
        sum = 0u; cnt = 0u; mine = 0u;
#pragma unroll
        for (unsigned j = 0; j < 16; ++j) { const unsigned c = xb_ld(&bar[XB_XCNT(j)]); sum += c; cnt += (c > 0u) ? 1u : 0u; mine = (j == x) ? c : mine; }
        if (sum == G) break;
        __builtin_amdgcn_s_sleep(1);
        if ((++sp & 255u) == 0u) { if (xb_ld(&bar[XB_TMO])) break; if (sp > XB_SPIN_CAP) { atomicAdd(&bar[XB_TMO], 1u); break; } }
    }
    nloc = mine > 0u ? mine : 1u; nx = cnt > 0u ? cnt : 1u;
}

__device__ __forceinline__ void xcd_barrier(const XcdBarrier& b) {
    asm volatile("s_waitcnt vmcnt(0)" ::: "memory");
    __syncthreads();
    if (threadIdx.x == 0) {
        unsigned* bar = b.bar;
        __builtin_amdgcn_s_waitcnt(0);
        unsigned nloc = b.st[0], nx = b.st[1];
        if (nloc == 0u) { xcd_barrier_complete(bar, b.x, nloc, nx); b.st[0] = nloc; b.st[1] = nx; }
        const unsigned old = xb_add(&bar[XB_XSUB(b.x)], 1u);
        const unsigned gen = old / nloc;
        if (old + 1u == (gen + 1u) * nloc) {
            __builtin_amdgcn_fence(__ATOMIC_RELEASE, "agent");
            asm volatile("s_waitcnt vmcnt(0)" ::: "memory");
            const unsigned og = xb_add(&bar[XB_TOP], 1u);
            const unsigned tg = og / nx;
            if (og + 1u == (tg + 1u) * nx) xb_add(&bar[XB_TOPGEN], 1u);
            else XB_SPIN(xb_ld(&bar[XB_TOPGEN]) == tg, bar);
            __builtin_amdgcn_fence(__ATOMIC_ACQUIRE, "agent");
            xb_add(&bar[XB_XGEN(b.x)], 1u);
            asm volatile("s_waitcnt vmcnt(0)" ::: "memory");
        } else {
            XB_SPIN(xb_ld(&bar[XB_XGEN(b.x)]) == gen, bar);
            __builtin_amdgcn_fence(__ATOMIC_ACQUIRE, "agent");
            asm volatile("s_waitcnt vmcnt(0)" ::: "memory");
        }
    }
    __syncthreads();
}
__device__ __forceinline__ float wave_sum(float v) {
#pragma unroll
    for (int o = 1; o < 64; o <<= 1) v += __shfl_xor(v, o);
    return v;
}
__device__ __forceinline__ void p0_transpose_item(const float* W, int ldw, const float* gain, bf16* dst, int ldd, int k0, int n0, int drow0, LAS float* scr, int lane) {
    const int r8 = lane >> 3, c4 = lane & 7;
    f32x4 v[8]; float gk[8];
#pragma unroll
    for (int i = 0; i < 8; ++i) v[i] = *(const GAS f32x4*)(W + (size_t)(k0 + 8 * i + r8) * ldw + n0 + 4 * c4);
#pragma unroll
    for (int i = 0; i < 8; ++i) gk[i] = gain ? gain[k0 + 8 * i + r8] : 1.f;
#pragma unroll
    for (int i = 0; i < 8; ++i) { LAS float* d = scr + (8 * i + r8) * 33 + 4 * c4; d[0] = v[i].x * gk[i]; d[1] = v[i].y * gk[i]; d[2] = v[i].z * gk[i]; d[3] = v[i].w * gk[i]; }
    LDS_WAIT(); asm volatile("" ::: "memory");
    const int c = lane & 7;
#pragma unroll
    for (int j = 0; j < 4; ++j) { const int n = (lane >> 3) + 8 * j; const LAS float* s = scr + (8 * c) * 33 + n;
        v4u o; o.x = pk2(s[0 * 33], s[1 * 33]); o.y = pk2(s[2 * 33], s[3 * 33]); o.z = pk2(s[4 * 33], s[5 * 33]); o.w = pk2(s[6 * 33], s[7 * 33]);
        *(GAS v4u*)(dst + (size_t)(drow0 + n) * ldd + k0 + 8 * c) = o; }
    LDS_WAIT(); asm volatile("" ::: "memory");
}
__device__ __forceinline__ int map_up(int n0, int which) { return 256 * (n0 >> 7) + 128 * which + (n0 & 127); }
__device__ __forceinline__ int map_win(int n0) {
    const int kind = n0 >> 9, w = n0 & 511, half = w >> 8, t = w & 255;
    if (kind == 0 || kind == 1 || kind == 3 || kind == 4) { const int wc = t >> 6, bj = (t >> 5) & 1; return kind * 512 + half * 256 + 128 * bj + 32 * wc; }
    return n0;
}
__device__ __forceinline__ void rms_rows2_to_bf16(const float* x0, const float* x1, const float* g, bf16* o0, bf16* o1, int lane) {
    const GAS f32x4* xa = (const GAS f32x4*)x0 + lane; const GAS f32x4* xb = (const GAS f32x4*)x1 + lane; const GAS f32x4* gr = (const GAS f32x4*)g + lane;
    f32x4 va[4], vb[4]; float sa = 0.f, sb = 0.f;
#pragma unroll
    for (int j = 0; j < 4; ++j) { va[j] = xa[64 * j]; vb[j] = xb[64 * j]; }
#pragma unroll
    for (int j = 0; j < 4; ++j) { sa += (va[j].x * va[j].x + va[j].y * va[j].y) + (va[j].z * va[j].z + va[j].w * va[j].w); sb += (vb[j].x * vb[j].x + vb[j].y * vb[j].y) + (vb[j].z * vb[j].z + vb[j].w * vb[j].w); }
    const float ra = 1.0f / sqrtf(wave_sum(sa) * (1.0f / 1024.0f) + RMS_EPS), rb = 1.0f / sqrtf(wave_sum(sb) * (1.0f / 1024.0f) + RMS_EPS);
    GAS unsigned long long* pa = (GAS unsigned long long*)o0 + lane; GAS unsigned long long* pb = (GAS unsigned long long*)o1 + lane;
#pragma unroll
    for (int j = 0; j < 4; ++j) { const f32x4 gg = gr[64 * j];
        pa[64 * j] = (unsigned long long)pk2(va[j].x * ra * gg.x, va[j].y * ra * gg.y) | ((unsigned long long)pk2(va[j].z * ra * gg.z, va[j].w * ra * gg.w) << 32);
        pb[64 * j] = (unsigned long long)pk2(vb[j].x * rb * gg.x, vb[j].y * rb * gg.y) | ((unsigned long long)pk2(vb[j].z * rb * gg.z, vb[j].w * rb * gg.w) << 32); }
}

__device__ __forceinline__ void cast_rows2_to_bf16(const float* x0, const float* x1, bf16* o0, bf16* o1, float* s0, float* s1, int lane) {
    const GAS f32x4* xa = (const GAS f32x4*)x0 + lane; const GAS f32x4* xb = (const GAS f32x4*)x1 + lane;
    f32x4 va[4], vb[4]; float sa = 0.f, sb = 0.f;
#pragma unroll
    for (int j = 0; j < 4; ++j) { va[j] = xa[64 * j]; vb[j] = xb[64 * j]; }
    GAS unsigned long long* pa = (GAS unsigned long long*)o0 + lane; GAS unsigned long long* pb = (GAS unsigned long long*)o1 + lane;
#pragma unroll
    for (int j = 0; j < 4; ++j) { sa += (va[j].x * va[j].x + va[j].y * va[j].y) + (va[j].z * va[j].z + va[j].w * va[j].w); sb += (vb[j].x * vb[j].x + vb[j].y * vb[j].y) + (vb[j].z * vb[j].z + vb[j].w * vb[j].w);
        pa[64 * j] = (unsigned long long)pk2(va[j].x, va[j].y) | ((unsigned long long)pk2(va[j].z, va[j].w) << 32);
        pb[64 * j] = (unsigned long long)pk2(vb[j].x, vb[j].y) | ((unsigned long long)pk2(vb[j].z, vb[j].w) << 32); }
    sa = wave_sum(sa); sb = wave_sum(sb);
    if (lane == 0) { *s0 = sa; *s1 = sb; }
}

struct Args { const float* in[28]; float* out; unsigned char* ws; int ph_lo, ph_hi, li, pad; };
__device__ const float ROPE_INV[32] = {1.000000000e+00f, 7.498942614e-01f, 5.623413324e-01f, 4.216965139e-01f, 3.162277639e-01f, 2.371373773e-01f, 1.778279394e-01f, 1.333521307e-01f, 1.000000015e-01f, 7.498941571e-02f, 5.623413250e-02f, 4.216965288e-02f, 3.162277490e-02f, 2.371373773e-02f, 1.778279431e-02f, 1.333521493e-02f, 9.999999776e-03f, 7.498941850e-03f, 5.623413250e-03f, 4.216964822e-03f, 3.162277630e-03f, 2.371373586e-03f, 1.778279431e-03f, 1.333521446e-03f, 1.000000047e-03f, 7.498942432e-04f, 5.623413017e-04f, 4.216965172e-04f, 3.162277571e-04f, 2.371373703e-04f, 1.778279402e-04f, 1.333521504e-04f};

struct Frame {
    LAS unsigned char* lds; volatile LAS unsigned* MISC; gu32* ctl;
    int tid, wave, vcu, G;
};

__device__ __forceinline__ void p0_prologue(Frame& F, const Args& a) {
    int tid_ = F.tid; asm volatile("" : "+v"(tid_)); const int lane_ = tid_ & 63;
    unsigned char* ws = a.ws;
    LAS float* scr = (LAS float*)(F.lds + F.wave * 16384);
    const bool split = F.G == 256, member = split && (F.vcu & 7) == 0;
    const int gw = (!split ? F.vcu : member ? (F.vcu >> 3) : F.vcu - (F.vcu >> 3) - 1) * NWAVES + F.wave, NGW = (!split ? F.G : member ? 32 : 224) * NWAVES;
    const float* x = a.in[0]; const float* mem = a.in[1];
    constexpr int I_UP = 16 * 88, I_DN = 44 * 32, I_IN = 16 * 112, I_G = 16 * 96, I_B = 8 * 32, I_O = 16 * 32;
    constexpr int NITEMS = 2 * (2 * I_UP + I_DN) + I_IN + I_G + 3 * I_B + 2 * I_O;
    const int it_lo = member ? NITEMS - I_O : 0, it_hi = (split && !member) ? NITEMS - I_O : NITEMS;
    for (int it = it_lo + gw; it < it_hi; it += NGW) {
        int r = it;
#define TR_ITEM(cnt, W, Kd, Nd, gain, dstoff, ldd, MAP) if (r < (cnt)) { const int nblk = (Nd) / 32, kb = r / nblk, nb = r % nblk, n0 = 32 * nb; \
            p0_transpose_item((W), (Nd), (gain), (bf16*)(ws + (dstoff)), (ldd), 64 * kb, n0, (MAP), scr, lane_); continue; } r -= (cnt);
        TR_ITEM(I_UP, a.in[3], 1024, FF, a.in[2], WS_W1UP, 1024, map_up(n0, 0))
        TR_ITEM(I_UP, a.in[4], 1024, FF, a.in[2], WS_W1UP, 1024, map_up(n0, 1))
        TR_ITEM(I_DN, a.in[5], FF, 1024, nullptr, WS_W1DN, FF, n0)
        TR_ITEM(I_UP, a.in[24], 1024, FF, a.in[23], WS_W2UP, 1024, map_up(n0, 0))
        TR_ITEM(I_UP, a.in[25], 1024, FF, a.in[23], WS_W2UP, 1024, map_up(n0, 1))
        TR_ITEM(I_DN, a.in[26], FF, 1024, nullptr, WS_W2DN, FF, n0)
        TR_ITEM(I_IN, a.in[7], 1024, INC, a.in[6], WS_WIN, 1024, map_win(n0))
        TR_ITEM(I_G, a.in[19], 1024, GC, a.in[6], WS_WG, 1024, n0)
        TR_ITEM(I_B, a.in[21], 512, 1024, nullptr, WS_WB, 512, n0)
        TR_ITEM(I_B, a.in[21] + 512 * 1024, 512, 1024, nullptr, WS_WB, 512, 1024 + n0)
        TR_ITEM(I_B, a.in[21] + 2 * 512 * 1024, 512, 1024, nullptr, WS_WB, 512, 2048 + n0)
        TR_ITEM(I_O, a.in[22], 1024, 1024, nullptr, WS_WO, 1024, n0)
        TR_ITEM(I_O, a.in[16], 1024, 1024, nullptr, WS_WM, 1024, n0)
#undef TR_ITEM
    }
    if (!member) { float* ss0 = (float*)(ws + WS_SS0); bf16* xb = (bf16*)(ws + WS_B1);
      for (int m = gw; m < M / 4; m += NGW) {
          const GAS f32x4* xr[4]; f32x4 v[4][4]; float sq[4];
#pragma unroll
          for (int q = 0; q < 4; ++q) { xr[q] = (const GAS f32x4*)(x + (size_t)(m + q * (M / 4)) * DM) + lane_;
#pragma unroll
              for (int j = 0; j < 4; ++j) v[q][j] = xr[q][64 * j]; }
#pragma unroll
          for (int q = 0; q < 4; ++q) { GAS unsigned long long* po = (GAS unsigned long long*)(xb + (size_t)(m + q * (M / 4)) * DM) + lane_; float s = 0.f;
#pragma unroll
              for (int j = 0; j < 4; ++j) { const f32x4 t = v[q][j]; s += (t.x * t.x + t.y * t.y) + (t.z * t.z + t.w * t.w);
                  po[64 * j] = (unsigned long long)pk2(t.x, t.y) | ((unsigned long long)pk2(t.z, t.w) << 32); }
              sq[q] = wave_sum(s); }
          if (lane_ == 0) {
#pragma unroll
              for (int q = 0; q < 4; ++q) ss0[m + q * (M / 4)] = sq[q]; } } }
    if (!split || member) for (int m = gw; m < MMEM / 2; m += NGW) rms_rows2_to_bf16(mem + (size_t)m * DM, mem + (size_t)(m + MMEM / 2) * DM, a.in[15], (bf16*)(ws + WS_MEMN) + (size_t)m * DM, (bf16*)(ws + WS_MEMN) + (size_t)(m + MMEM / 2) * DM, lane_);
    if (member) {
        unsigned* bar = (unsigned*)(F.ctl + CW_BAR); unsigned* cnt = (unsigned*)(F.ctl + CW_MEMGRP);
        asm volatile("s_waitcnt vmcnt(0)" ::: "memory");
        __syncthreads();
        if (F.tid == 0) {
            __builtin_amdgcn_fence(__ATOMIC_RELEASE, "agent");
            asm volatile("s_waitcnt vmcnt(0)" ::: "memory");
            (void)xb_add(cnt, 1u);
            XB_SPIN(xb_ld(cnt) < 32u, bar);
            __builtin_amdgcn_fence(__ATOMIC_ACQUIRE, "agent");
            asm volatile("s_waitcnt vmcnt(0)" ::: "memory");
        }
        __syncthreads();
        const int bx = (int)blockIdx.x;
        pg8::Gemm g{(const pg8::bf16_t*)(ws + WS_MEMN), (const pg8::bf16_t*)(ws + WS_WM), MMEM, DM, DM}; pg8::StaticOrder S; S.init(MMEM, DM, 32, (bx >> 6) * 8 + (bx & 7));
        pg8::EpiPlain<0> E{(pg8::bf16_t*)(ws + WS_MKV), 1024, nullptr, nullptr};
        pg8::gemm_phase<pg8::EpiPlain<0>, pg8::StaticOrder, true, true>(F.lds, g, S, E);
    }
    if (!split || member) { float* cosT = (float*)(ws + WS_COS); float* sinT = (float*)(ws + WS_SIN);
      for (int idx = (split ? (F.vcu >> 3) : F.vcu) * 512 + F.tid; idx < SEQ * 32; idx += (split ? 32 : F.G) * 512) {
          const int pos = idx >> 5, j = idx & 31; const float ang = (float)pos * ROPE_INV[j];
          const double xd = (double)ang; const double kq = rint(xd * 0.15915494309189535); const double rr = xd - kq * 6.283185307179586476925; const double r2 = rr * rr;
          double cs = 1.0, sn = 1.0, tc = 1.0, ts = 1.0;
#pragma unroll
          for (int n = 1; n <= 14; ++n) { tc = -tc * r2 * (1.0 / (double)((2 * n - 1) * (2 * n))); ts = -ts * r2 * (1.0 / (double)((2 * n) * (2 * n + 1))); cs += tc; sn += ts; }
          cosT[idx] = (float)cs; sinT[idx] = (float)(sn * rr); } }
    if (blockIdx.x == 1 % F.G && F.tid < 256) { const int k = F.tid >> 6, d = F.tid & 63; const float* src = k == 0 ? a.in[8] : k == 1 ? a.in[9] : k == 2 ? a.in[12] : a.in[13];
        ((float*)(ws + WS_MISC))[64 + F.tid] = src[d] * ((k & 1) ? 1.0f : 0.125f * LOG2E_F); }
    if (blockIdx.x == 0 && F.wave == 0) { const float* lp = a.in[10];
        const float s01 = wave_sum(lp[lane_] * lp[64 + lane_]), s23 = wave_sum(lp[128 + lane_] * lp[192 + lane_]);
        if (lane_ == 0) ((float*)(ws + WS_MISC))[0] = expf(s01) - expf(s23) + 0.2f; }
}

__device__ __forceinline__ void p2_mknorm(Frame& F, const Args& a) {
    int tid_ = F.tid; asm volatile("" : "+v"(tid_)); const int lane_ = tid_ & 63;
    const bf16* mkv = (const bf16*)(a.ws + WS_MKV); bf16* mkn = (bf16*)(a.ws + WS_MKN);
    const float* gk = a.in[18]; const float* gq = a.in[17];
    const int gw = F.vcu * NWAVES + F.wave, NGW = F.G * NWAVES;
    const float sc = 0.08838834764831845f * LOG2E_F;
    for (int it = gw; it < MMEM * 4; it += NGW) { const int t = it >> 2, h = it & 3;
        const unsigned u = *(const unsigned*)(mkv + (size_t)t * 1024 + h * 128 + 2 * lane_);
        const float v0 = bf2f((unsigned short)(u & 0xffffu)), v1 = bf2f((unsigned short)(u >> 16));
        const float r = 1.0f / sqrtf(wave_sum(v0 * v0 + v1 * v1) * (1.0f / 128.0f) + RMS_EPS);
        const int d = 2 * lane_;
        *(unsigned*)(mkn + (size_t)t * 512 + h * 128 + d) = pk2(v0 * r * gk[d] * gq[d] * sc, v1 * r * gk[d + 1] * gq[d + 1] * sc); }
}

__device__ __forceinline__ void p9_final_norm(Frame& F, const Args& a) {
    int tid_ = F.tid; asm volatile("" : "+v"(tid_)); const int lane_ = tid_ & 63;
    const float* ss = (const float*)(a.ws + WS_SS3); const float* g = a.in[27]; float* out = a.out; const bf16* x3 = (const bf16*)(a.ws + WS_X3B);
    const int gw = F.vcu * NWAVES + F.wave, NGW = F.G * NWAVES;
    f32x4 gg[2][2];
#pragma unroll
    for (int j = 0; j < 2; ++j) { gg[j][0] = *(const GAS f32x4*)(g + 512 * j + 8 * lane_); gg[j][1] = *(const GAS f32x4*)(g + 512 * j + 8 * lane_ + 4); }
    for (int m = gw; m < M / 4; m += NGW) {
        v4u u[4][2]; float sv[4];
#pragma unroll
        for (int q = 0; q < 4; ++q) { sv[q] = ss[m + q * (M / 4)];
#pragma unroll
            for (int j = 0; j < 2; ++j) u[q][j] = *(const GAS v4u*)(x3 + (size_t)(m + q * (M / 4)) * DM + 512 * j + 8 * lane_); }
#pragma unroll
        for (int q = 0; q < 4; ++q) { const float r = 1.0f / sqrtf(sv[q] * (1.0f / 1024.0f) + RMS_EPS);
#pragma unroll
            for (int j = 0; j < 2; ++j) { const v4u w = u[q][j]; f32x4 v0, v1;
                v0[0] = __uint_as_float(w.x << 16); v0[1] = __uint_as_float(w.x & 0xffff0000u); v0[2] = __uint_as_float(w.y << 16); v0[3] = __uint_as_float(w.y & 0xffff0000u);
                v1[0] = __uint_as_float(w.z << 16); v1[1] = __uint_as_float(w.z & 0xffff0000u); v1[2] = __uint_as_float(w.w << 16); v1[3] = __uint_as_float(w.w & 0xffff0000u);
                GAS f32x4* o = (GAS f32x4*)(out + (size_t)(m + q * (M / 4)) * DM + 512 * j + 8 * lane_);
                o[0] = v0 * r * gg[j][0]; o[1] = v1 * r * gg[j][1]; } } }
}

namespace pg8 {
struct EpiFinal {
    static constexpr bool PERM = true, AFTER_DRAIN = false;
    const bf16_t* base; float* out; float* ss; const float* gain; unsigned* rbc; unsigned* bar; float alpha;
    __device__ __forceinline__ void pre(const Unit&, int, int) const {}
    __device__ __forceinline__ void operator()(const f32x4 (&acc)[2][2][4][2], const Unit& u, int wr, int wc, int fr, int fq) const {
        const int row0 = u.pm * BM + wr * 64 + fr, col0 = u.pn * BM + wc * 32 + 8 * fq;
        float qs[8];
#pragma unroll
        for (int ai = 0; ai < 2; ++ai) { u32x4 bb[4][2];
#pragma unroll
            for (int m = 0; m < 4; ++m)
#pragma unroll
                for (int bj = 0; bj < 2; ++bj) bb[m][bj] = *(const u32x4*)(base + (size_t)(row0 + ai * HALF + m * 16) * 1024 + col0 + bj * HALF);
#pragma unroll
            for (int m = 0; m < 4; ++m) { float q = 0.f;
#pragma unroll
                for (int bj = 0; bj < 2; ++bj) { f32x4 b0, b1; unpack8(bb[m][bj], b0, b1);
                    const f32x4 v0 = b0 + acc[ai][bj][m][0] * alpha, v1 = b1 + acc[ai][bj][m][1] * alpha;
                    q += (v0[0] * v0[0] + v0[1] * v0[1]) + (v0[2] * v0[2] + v0[3] * v0[3]) + (v1[0] * v1[0] + v1[1] * v1[1]) + (v1[2] * v1[2] + v1[3] * v1[3]); }
                q += __shfl_xor(q, 16); q += __shfl_xor(q, 32); qs[ai * 4 + m] = q; }
            asm volatile("" ::: "memory"); }
        if (fq == 0) {
#pragma unroll
            for (int j = 0; j < 8; ++j) { const float old = atomicAdd(ss + row0 + (j >> 2) * HALF + (j & 3) * 16, qs[j]); asm volatile("" :: "v"(old)); } }
        asm volatile("s_waitcnt vmcnt(0)" ::: "memory");
        __syncthreads();
        if (threadIdx.x == 0) { (void)xb_add(&rbc[u.pm], 1u); XB_SPIN(xb_ld(&rbc[u.pm]) < 4u, bar); }
        __syncthreads();
        f32x4 gv[2][2];
#pragma unroll
        for (int bj = 0; bj < 2; ++bj)
#pragma unroll
            for (int n = 0; n < 2; ++n) gv[bj][n] = *(const f32x4*)(gain + col0 + bj * HALF + 4 * n);
        float sv[8];
#pragma unroll
        for (int j = 0; j < 8; ++j) sv[j] = __hip_atomic_load(ss + row0 + (j >> 2) * HALF + (j & 3) * 16, __ATOMIC_RELAXED, __HIP_MEMORY_SCOPE_AGENT);
#pragma unroll
        for (int ai = 0; ai < 2; ++ai) { u32x4 bb[4][2];
#pragma unroll
            for (int m = 0; m < 4; ++m)
#pragma unroll
                for (int bj = 0; bj < 2; ++bj) bb[m][bj] = *(const u32x4*)(base + (size_t)(row0 + ai * HALF + m * 16) * 1024 + col0 + bj * HALF);
#pragma unroll
            for (int m = 0; m < 4; ++m) { const size_t off = (size_t)(row0 + ai * HALF + m * 16) * 1024 + col0;
                const float r = __builtin_amdgcn_rsqf(sv[ai * 4 + m] * (1.0f / 1024.0f) + RMS_EPS);
#pragma unroll
                for (int bj = 0; bj < 2; ++bj) { f32x4 b0, b1; unpack8(bb[m][bj], b0, b1);
                    const f32x4 v0 = (b0 + acc[ai][bj][m][0] * alpha) * r * gv[bj][0], v1 = (b1 + acc[ai][bj][m][1] * alpha) * r * gv[bj][1];
                    *(f32x4*)(out + off + bj * HALF) = v0; *(f32x4*)(out + off + bj * HALF + 4) = v1; } }
            asm volatile("" ::: "memory"); }
    }
};
}
typedef LAS float* ALAS_F;
__global__ void __launch_bounds__(NWAVES * 64, 2) layer_fwd(Args args) {
    extern __shared__ __attribute__((aligned(16))) unsigned char lds[];
    Frame F;
    F.lds = (LAS unsigned char*)lds;
    F.MISC = (volatile LAS unsigned*)(F.lds + MISC_OFF);
    F.tid = threadIdx.x; F.wave = __builtin_amdgcn_readfirstlane(F.tid >> 6);
    F.G = gridDim.x; { const int bx = blockIdx.x; F.vcu = (F.G % 8 == 0) ? (bx % 8) * (F.G / 8) + bx / 8 : bx; }
    unsigned char* ws = args.ws;
    F.ctl = (gu32*)(ws + WS_CTL);
    for (int u = F.tid; u < (LDS_BYTES - LDSCTL_OFF) / 4; u += NWAVES * 64) ((LAS unsigned*)(F.lds + LDSCTL_OFF))[u] = 0u;
    __syncthreads();
    XcdBarrier bar; bar.bar = (unsigned*)(F.ctl + CW_BAR); bar.x = 0; bar.st = nullptr;
    if (N_LAUNCHES == 1) bar = xcd_barrier_post((unsigned*)(F.ctl + CW_BAR), F.MISC + 8);
#define GRID_BAR() do { if (N_LAUNCHES == 1) xcd_barrier(bar); } while (0)
    const int lo = args.ph_lo, hi = args.ph_hi;
#define IN(k) (lo <= (k) && (k) < hi)
#define BOTH(k) (IN(k) && IN((k) + 1))
    bf16* const W1UP = (bf16*)(ws + WS_W1UP); bf16* const W1DN = (bf16*)(ws + WS_W1DN); bf16* const W2UP = (bf16*)(ws + WS_W2UP); bf16* const W2DN = (bf16*)(ws + WS_W2DN);
    bf16* const WIN = (bf16*)(ws + WS_WIN); bf16* const WG = (bf16*)(ws + WS_WG); bf16* const WB = (bf16*)(ws + WS_WB); bf16* const WO = (bf16*)(ws + WS_WO); bf16* const WM = (bf16*)(ws + WS_WM);
    bf16* const B1 = (bf16*)(ws + WS_B1); bf16* const BIG = (bf16*)(ws + WS_BIG);
    float* const SS1 = (float*)(ws + WS_SS1); float* const SS2 = (float*)(ws + WS_SS2); float* const SS3 = (float*)(ws + WS_SS3);
    constexpr size_t SEC = (size_t)M * 512;
    const int cid = (int)blockIdx.x;

    if (IN(0)) { p0_prologue(F, args); if (BOTH(0)) GRID_BAR(); }

    if (IN(1)) {
        { pg8::Gemm g{B1, W1UP, M, 2 * FF, DM}; pg8::StaticOrder S; S.init(M, 2 * FF, F.G, cid);
          pg8::EpiUp E{(bf16*)(ws + WS_ACT1), FF, (const float*)(ws + WS_SS0)};
          pg8::gemm_phase<pg8::EpiUp, pg8::StaticOrder, true, true>(F.lds, g, S, E); }
        if (F.G != 256) { pg8::Gemm g{(const bf16*)(ws + WS_MEMN), WM, MMEM, DM, DM}; pg8::StaticOrder S; S.init(MMEM, DM, F.G, cid);
          pg8::EpiPlain<0> E{(bf16*)(ws + WS_MKV), 1024, nullptr, nullptr};
          pg8::gemm_phase<pg8::EpiPlain<0>, pg8::StaticOrder, true, true>(F.lds, g, S, E); }
        if (BOTH(1)) GRID_BAR();
    }

    if (IN(2)) {
        p2_mknorm(F, args);
        pg8::Gemm g{(const bf16*)(ws + WS_ACT1), W1DN, M, DM, FF}; pg8::StaticOrder S; S.init(M, DM, F.G, cid);
        pg8::EpiDown<true> E{B1, B1, SS1, 0.5f};
        pg8::gemm_phase<pg8::EpiDown<true>, pg8::StaticOrder, true, true>(F.lds, g, S, E);
        if (BOTH(2)) GRID_BAR();
    }

    if (IN(3)) {
        pg8::Gemm g{B1, WIN, M, INC, DM}; pg8::StaticOrder S; S.init(M, INC, F.G, cid);
        pg8::EpiProj E{BIG, SS1, (const float*)(ws + WS_MISC) + 64, (const float*)(ws + WS_COS), (const float*)(ws + WS_SIN)};
        pg8::gemm_phase<pg8::EpiProj, pg8::StaticOrder, true, true>(F.lds, g, S, E);
        if (BOTH(3)) GRID_BAR();
    }

    if (IN(4)) {
        bf16* aq = BIG; bf16* bq = BIG + SEC; bf16* cq = BIG + 2 * SEC; const bf16* ak = BIG + 3 * SEC; const bf16* av = BIG + 4 * SEC; const bf16* bk = BIG + 5 * SEC; const bf16* bv = BIG + 6 * SEC;
        const float lam = ((const float*)(ws + WS_MISC))[0];
#define A_DEC(u, B_, H_, Q_) const int v##B_ = (u) & 255, i##B_ = (u) >> 8, bh##B_ = v##B_ >> 3, s##B_ = v##B_ & 7; const int B_ = bh##B_ >> 2, H_ = bh##B_ & 3, Q_ = i##B_ == 0 ? s##B_ : i##B_ == 1 ? 15 - s##B_ : i##B_ == 2 ? 16 + s##B_ : 31 - s##B_
#define B_DEC(u, B_, H_, Q_) const int v##B_ = (u) & 255, i##B_ = (u) >> 8, bhp##B_ = v##B_ >> 3; const int B_ = bhp##B_ >> 2, H_ = bhp##B_ & 3, Q_ = (v##B_ & 7) * 4 + i##B_
        { att::Pre<4> P;
          { ALAS_F gsub = (ALAS_F)(F.lds + 98336); if (F.tid < 128) gsub[F.tid] = args.in[11][F.tid];
            if (F.vcu < 1024) { A_DEC(F.vcu, b0, h0, q0); att::preloadA(P, b0, h0, q0, aq, ak, av, F.tid); }
            for (int u = F.vcu; u < 1024; u += F.G) { A_DEC(u, bc, hc, qc); A_DEC(u + F.G, bn, hn, qn);
                att::unitA(bc, hc, qc, aq, ak, av, aq, gsub, lam, F.lds, F.tid, P, u + F.G < 1024, bn, hn, qn); } }
          att::setupB2(((F.vcu & 255) >> 3) & 3, args.in[14], F.lds, F.tid);
          if (F.vcu < 1024) { B_DEC(F.vcu, b1, h1, q1); att::preloadB2(P, b1, h1, q1, bq, bk, bv, F.tid); }
          for (int u = F.vcu; u < 1024; u += F.G) { B_DEC(u, bc, hc, qc); B_DEC(u + F.G, bn, hn, qn);
              if (F.G != 256) { asm volatile("s_waitcnt lgkmcnt(0)" ::: "memory"); __builtin_amdgcn_s_barrier(); att::setupB2(hc, args.in[14], F.lds, F.tid); }
              att::unitB2(bc, hc, qc, bq, bk, bv, bq, args.in[14], F.lds, F.tid, P, u + F.G < 1024, bn, hn, qn); } }
#undef A_DEC
#undef B_DEC
        if (F.G == 256) { const int bh = F.vcu >> 3;
            att::stageC_all(bh >> 2, bh & 3, (const bf16*)(ws + WS_MKN), (const bf16*)(ws + WS_MKV), F.lds, F.tid);
            for (int i = 0; i < 2; ++i) att::unitC_res(bh >> 2, bh & 3, (F.vcu & 7) * 2 + i, cq, cq, F.lds, F.tid);
        } else
        for (int u = F.vcu; u < 512; u += F.G) { const int v = u & 255, i = u >> 8, bh = v >> 3, qb = (v & 7) * 2 + i;
            att::unitC(bh >> 2, bh & 3, qb, cq, (const bf16*)(ws + WS_MKN), (const bf16*)(ws + WS_MKV), cq, F.lds, F.tid); }
        if (BOTH(4)) GRID_BAR();
    }

    if (IN(5)) {
        pg8::GateBranchOrder S; S.init(F.G, cid, B1, WG, BIG, WB);
        unsigned char* scr = ws + WS_GBSCR + (size_t)blockIdx.x * (192 * 1024);
        pg8::EpiGB E{SS1, args.in[20], (bf16*)args.out, (pg8::u32x4*)scr, (pg8::u32x4*)(scr + 64 * 1024)};
        pg8::gemm_phase_vk<pg8::EpiGB, pg8::GateBranchOrder>(F.lds, S, E);
        if (BOTH(5)) GRID_BAR();
    }

    if (IN(6)) {
        pg8::Gemm g{(const bf16*)args.out, WO, M, DM, DM}; pg8::StaticOrder S; S.init(M, DM, F.G, cid);
        pg8::EpiDown<true> E{B1, (bf16*)(ws + WS_X2B), SS2, 1.0f};
        pg8::gemm_phase<pg8::EpiDown<true>, pg8::StaticOrder, true, true>(F.lds, g, S, E);
        if (BOTH(6)) GRID_BAR();
    }

    if (IN(7)) {
        pg8::Gemm g{(const bf16*)(ws + WS_X2B), W2UP, M, 2 * FF, DM}; pg8::StaticOrder S; S.init(M, 2 * FF, F.G, cid);
        pg8::EpiUp E{(bf16*)(ws + WS_ACT2), FF, SS2};
        pg8::gemm_phase<pg8::EpiUp, pg8::StaticOrder, true, true>(F.lds, g, S, E);
        if (BOTH(7)) GRID_BAR();
    }

    if (IN(8)) {
        pg8::Gemm g{(const bf16*)(ws + WS_ACT2), W2DN, M, DM, FF}; pg8::StaticOrder S; S.init(M, DM, F.G, cid);
        if (N_LAUNCHES == 1 && F.G == 256) {
            pg8::EpiFinal E{(const bf16*)(ws + WS_X2B), args.out, SS3, args.in[27], (unsigned*)(F.ctl + CW_RB), (unsigned*)(F.ctl + CW_BAR), 0.5f};
            pg8::gemm_phase<pg8::EpiFinal, pg8::StaticOrder, true, true>(F.lds, g, S, E);
            return;
        }
        pg8::EpiDown<true> E{(const bf16*)(ws + WS_X2B), (bf16*)(ws + WS_X3B), SS3, 0.5f};
        pg8::gemm_phase<pg8::EpiDown<true>, pg8::StaticOrder, true, true>(F.lds, g, S, E);
        if (BOTH(8)) GRID_BAR();
    }

    if (IN(9)) p9_final_norm(F, args);
#undef IN
#undef BOTH
#undef GRID_BAR
}

extern "C" void kernel_launch(void* const* d_in, const int* in_sizes, int n_in, void* d_out, int out_size, void* d_ws, size_t ws_size, hipStream_t stream) {
    static int grid = 0;
    if (grid == 0) {
        if (n_in != 28 || in_sizes[0] != M * DM || out_size != M * DM || ws_size < WS_END) { fprintf(stderr, "kernel_launch: unexpected shapes (n_in %d, in0 %d, out %d, ws %zu)\n", n_in, n_in > 0 ? in_sizes[0] : -1, out_size, ws_size); grid = -1; return; }
        int dev = 0, cus = 0, per_cu = 0;
        if (hipGetDevice(&dev) != hipSuccess || hipDeviceGetAttribute(&cus, hipDeviceAttributeMultiprocessorCount, dev) != hipSuccess) { grid = -1; return; }
        if (hipFuncSetAttribute((const void*)layer_fwd, hipFuncAttributeMaxDynamicSharedMemorySize, LDS_BYTES) != hipSuccess) { fprintf(stderr, "kernel_launch: hipFuncSetAttribute failed\n"); grid = -1; return; }
        if (hipOccupancyMaxActiveBlocksPerMultiprocessor(&per_cu, (const void*)layer_fwd, NWAVES * 64, LDS_BYTES) != hipSuccess || per_cu < 1) { fprintf(stderr, "kernel_launch: occupancy query says %d blocks per CU\n", per_cu); (void)hipGetLastError(); grid = -1; return; }
        grid = cus;
    }
    if (grid < 0) return;
    if (hipMemsetAsync((char*)d_ws + WS_CTL, 0, CTL_ZERO_BYTES, stream) != hipSuccess) return;
    Args a{};
    for (int i = 0; i < 28; ++i) a.in[i] = (const float*)d_in[i];
    a.out = (float*)d_out; a.ws = (unsigned char*)d_ws;
    for (int li = 0; li < N_LAUNCHES; ++li) {
        a.ph_lo = (N_LAUNCHES == 1) ? 0 : li; a.ph_hi = (N_LAUNCHES == 1) ? N_PHASES : li + 1; a.li = li;
        hipLaunchKernelGGL(layer_fwd, dim3(grid), dim3(NWAVES * 64), LDS_BYTES, stream, a);
        const hipError_t le = hipPeekAtLastError();
        if (le != hipSuccess) { fprintf(stderr, "kernel_launch: launch %d failed: %s\n", li, hipGetErrorName(le)); break; }
    }
}
```
